# Optimizing an MI355X kernel written in HIP

```python
import jax, jax.numpy as jnp
from jax import lax
import numpy as np

D_MODEL = 1024
BATCH = 2
SEQ = 8192
DEPTH = 1

D_MIX = D_MODEL
CONV_WIDTH = D_MIX // 2
CONV_K = 3
RWKV_WIDTH = D_MIX - CONV_WIDTH
RWKV_HEAD = 64
RWKV_HEADS = RWKV_WIDTH // RWKV_HEAD
LORA_DECAY = 64
LORA_ICLR = 64
LORA_GATE = 128
RWKV_COLS = 3 * RWKV_WIDTH + LORA_DECAY + LORA_ICLR + LORA_GATE
IN_COLS = 3 * CONV_WIDTH + RWKV_COLS
N_EXPERTS = 32
TOP_K = 4
D_FF = D_MODEL
SWIGLU_LIMIT = 7.0
SWIGLU_ALPHA = 1.702
EXPERT_BLOCK = 128
RMS_EPS = 1e-5
GN_EPS = 64e-5

kernel_name = "hybrid_shortconv_rwkv7_moe_block"


def rms_norm(x, w):
    xf = x.astype(jnp.float32)
    y = xf * lax.rsqrt(jnp.mean(xf * xf, axis=-1, keepdims=True) + RMS_EPS)
    return (y * w.astype(jnp.float32)).astype(x.dtype)


def token_shift(p, mu):
    prev = jnp.pad(p, ((0, 0), (1, 0), (0, 0)))[:, :-1]
    return p + (prev - p) * mu


def causal_dwconv(u, w):
    S = u.shape[1]
    up = jnp.pad(u, ((0, 0), (CONV_K - 1, 0), (0, 0)))
    y = w[0] * up[:, 0:S]
    for j in range(1, CONV_K):
        y = y + w[j] * up[:, j:j + S]
    return y


def rwkv7_scan(r, w, k, v, a, b):
    Bsz, S, H, N = r.shape

    def step(state, inp):
        r_t, w_t, k_t, v_t, a_t, b_t = inp
        sa = jnp.einsum('bhij,bhj->bhi', state, a_t)
        state = (state * w_t[:, :, None, :]
                 + sa[..., :, None] * b_t[..., None, :]
                 + v_t[..., :, None] * k_t[..., None, :])
        y_t = jnp.einsum('bhij,bhj->bhi', state, r_t)
        return state, y_t

    xs = (jnp.moveaxis(r, 1, 0), jnp.moveaxis(w, 1, 0), jnp.moveaxis(k, 1, 0),
          jnp.moveaxis(v, 1, 0), jnp.moveaxis(a, 1, 0), jnp.moveaxis(b, 1, 0))
    s0 = jnp.zeros((Bsz, H, N, N), jnp.float32)
    _, ys = lax.scan(step, s0, xs)
    return jnp.moveaxis(ys, 0, 1)


def hybrid_mixer(xn, w_in, conv_w, mu_shift, w0, w_decay_up, a0, w_iclr_up, w_gate_up,
                 k_k, k_a, r_k, ln_x_w, ln_x_b, w_out):
    f32 = jnp.float32
    Bsz, S, _ = xn.shape
    H, N = RWKV_HEADS, RWKV_HEAD
    p = xn @ w_in
    c_b, c_c, c_h, p_rwkv = jnp.split(p, [CONV_WIDTH, 2 * CONV_WIDTH, 3 * CONV_WIDTH], axis=-1)

    y_conv = c_b * causal_dwconv(c_c * c_h, conv_w)

    q = token_shift(p_rwkv, mu_shift)
    o1 = 3 * RWKV_WIDTH
    r, k, v, d_w, d_a, d_g = jnp.split(
        q, [RWKV_WIDTH, 2 * RWKV_WIDTH, o1, o1 + LORA_DECAY, o1 + LORA_DECAY + LORA_ICLR], axis=-1)
    w_log = -jax.nn.softplus(-(w0 + jnp.tanh(d_w) @ w_decay_up).astype(f32)) - 0.5
    decay = jnp.exp(-jnp.exp(w_log))
    iclr = jax.nn.sigmoid((a0 + d_a @ w_iclr_up).astype(f32))
    g = jax.nn.sigmoid(d_g) @ w_gate_up

    def heads(t):
        return t.astype(f32).reshape(Bsz, S, H, N)

    r, k, v, decay, iclr = heads(r), heads(k), heads(v), heads(decay), heads(iclr)
    kk = k * k_k.astype(f32).reshape(H, N)
    kk = kk / jnp.maximum(jnp.linalg.norm(kk, axis=-1, keepdims=True), 1e-12)
    k = k * (1.0 + (iclr - 1.0) * k_a.astype(f32).reshape(H, N))
    y = rwkv7_scan(r, decay, k, v, -kk, kk * iclr)
    mean = jnp.mean(y, axis=-1, keepdims=True)
    var = jnp.mean(jnp.square(y - mean), axis=-1, keepdims=True)
    y = ((y - mean) * lax.rsqrt(var + GN_EPS) * ln_x_w.astype(f32).reshape(H, N)
         + ln_x_b.astype(f32).reshape(H, N))
    y = y + jnp.sum(r * k * r_k.astype(f32), axis=-1, keepdims=True) * v
    y_rwkv = y.reshape(Bsz, S, RWKV_WIDTH).astype(xn.dtype) * g

    return jnp.concatenate([y_conv, y_rwkv], axis=-1) @ w_out


def moe_ffn(xn, router_w, router_b, gu_w, gu_b, dn_w, dn_b):
    f32 = jnp.float32
    Bsz, S, D = xn.shape
    T = Bsz * S
    xt = xn.reshape(T, D)
    logits = xt.astype(f32) @ router_w.astype(f32) + router_b.astype(f32)
    top_vals, top_idx = lax.top_k(logits, TOP_K)
    gates = jax.nn.softmax(top_vals, axis=-1)

    n_pairs = T * TOP_K
    flat_e = top_idx.reshape(-1).astype(jnp.int32)
    flat_tok = jnp.arange(n_pairs, dtype=jnp.int32) // TOP_K
    flat_g = gates.reshape(-1)
    order = jnp.argsort(flat_e)
    se = flat_e[order]
    counts = jnp.bincount(flat_e, length=N_EXPERTS)
    starts = jnp.cumsum(counts) - counts
    pcounts = (counts + EXPERT_BLOCK - 1) // EXPERT_BLOCK * EXPERT_BLOCK
    pends = jnp.cumsum(pcounts)
    pstarts = pends - pcounts
    dest = pstarts[se] + (jnp.arange(n_pairs, dtype=jnp.int32) - starts[se])
    n_rows = -(-n_pairs // EXPERT_BLOCK) * EXPERT_BLOCK + N_EXPERTS * EXPERT_BLOCK
    n_blocks = n_rows // EXPERT_BLOCK
    row_tok = jnp.zeros((n_rows,), jnp.int32).at[dest].set(flat_tok[order])
    row_gate = jnp.zeros((n_rows,), f32).at[dest].set(flat_g[order])
    blk_e = jnp.minimum(
        jnp.searchsorted(pends, jnp.arange(n_blocks, dtype=jnp.int32) * EXPERT_BLOCK, side='right'),
        N_EXPERTS - 1).astype(jnp.int32)
    xs = xt[row_tok].reshape(n_blocks, EXPERT_BLOCK, D)

    def expert_block(args):
        xb, e = args
        h = xb @ gu_w[e] + gu_b[e]
        x_glu = jnp.minimum(h[:, 0::2], SWIGLU_LIMIT)
        x_lin = jnp.clip(h[:, 1::2], -SWIGLU_LIMIT, SWIGLU_LIMIT)
        act = x_glu * jax.nn.sigmoid(SWIGLU_ALPHA * x_glu) * (x_lin + 1.0)
        return act @ dn_w[e] + dn_b[e]

    yb = lax.map(expert_block, (xs, blk_e)).reshape(n_rows, D)
    contrib = (yb.astype(f32) * row_gate[:, None]).astype(xt.dtype)
    y = jnp.zeros((T, D), xt.dtype).at[row_tok].add(contrib)
    return y.reshape(Bsz, S, D)


def setup_inputs(seed: int = 0) -> dict:
    key = jax.random.key(seed)
    ks = jax.random.split(key, 26)
    f32 = jnp.float32
    L, D, H, N = DEPTH, D_MODEL, RWKV_HEADS, RWKV_HEAD

    def nrm(k, shape, scale):
        return jax.random.normal(k, shape, f32) * scale

    return {
        "x": nrm(ks[0], (BATCH, SEQ, D), 1.0),
        "norm_mix_w": 1.0 + nrm(ks[1], (L, D), 0.02),
        "w_in": nrm(ks[2], (L, D, IN_COLS), D ** -0.5),
        "conv_w": nrm(ks[3], (L, CONV_K, CONV_WIDTH), CONV_K ** -0.5),
        "mu_shift": jax.random.uniform(ks[4], (L, RWKV_COLS), f32, 0.0, 1.0),
        "w0": jax.random.uniform(ks[5], (L, RWKV_WIDTH), f32, -6.0, 1.0),
        "w_decay_up": nrm(ks[6], (L, LORA_DECAY, RWKV_WIDTH), 0.1),
        "a0": nrm(ks[7], (L, RWKV_WIDTH), 0.3),
        "w_iclr_up": nrm(ks[8], (L, LORA_ICLR, RWKV_WIDTH), 0.1),
        "w_gate_up": nrm(ks[9], (L, LORA_GATE, RWKV_WIDTH), LORA_GATE ** -0.5),
        "k_k": 0.85 + nrm(ks[10], (L, RWKV_WIDTH), 0.05),
        "k_a": 1.0 + nrm(ks[11], (L, RWKV_WIDTH), 0.05),
        "r_k": nrm(ks[12], (L, H, N), 0.1),
        "ln_x_w": 1.0 + nrm(ks[13], (L, RWKV_WIDTH), 0.02),
        "ln_x_b": nrm(ks[14], (L, RWKV_WIDTH), 0.02),
        "w_out": nrm(ks[15], (L, D_MIX, D), D_MIX ** -0.5),
        "norm_ffn_w": 1.0 + nrm(ks[16], (L, D), 0.02),
        "router_w": nrm(ks[17], (L, D, N_EXPERTS), D ** -0.5),
        "router_b": nrm(ks[18], (L, N_EXPERTS), 0.01),
        "gu_w": nrm(ks[19], (L, N_EXPERTS, D, 2 * D_FF), D ** -0.5),
        "gu_b": nrm(ks[20], (L, N_EXPERTS, 2 * D_FF), 0.01),
        "dn_w": nrm(ks[21], (L, N_EXPERTS, D_FF, D), D_FF ** -0.5),
        "dn_b": nrm(ks[22], (L, N_EXPERTS, D), 0.01),
        "norm_final_w": 1.0 + nrm(ks[23], (D,), 0.02),
    }


def reference(x, norm_mix_w, w_in, conv_w, mu_shift, w0, w_decay_up, a0, w_iclr_up, w_gate_up,
              k_k, k_a, r_k, ln_x_w, ln_x_b, w_out, norm_ffn_w, router_w, router_b,
              gu_w, gu_b, dn_w, dn_b, norm_final_w):
    h = x
    for l in range(DEPTH):
        h = h + hybrid_mixer(rms_norm(h, norm_mix_w[l]), w_in[l], conv_w[l], mu_shift[l], w0[l],
                             w_decay_up[l], a0[l], w_iclr_up[l], w_gate_up[l], k_k[l], k_a[l],
                             r_k[l], ln_x_w[l], ln_x_b[l], w_out[l])
        h = h + moe_ffn(rms_norm(h, norm_ffn_w[l]), router_w[l], router_b[l],
                        gu_w[l], gu_b[l], dn_w[l], dn_b[l])
    return rms_norm(h, norm_final_w)
```

```cpp
#include <hip/hip_runtime.h>
#include <cstdint>
#include <cstdio>
__device__ __forceinline__ int hw_lane_id() { return (int)__builtin_amdgcn_mbcnt_hi(0xffffffffu, __builtin_amdgcn_mbcnt_lo(0xffffffffu, 0u)); }
namespace pg8 {
#define PG8_LAS __attribute__((address_space(3)))
typedef unsigned short bf16_t;
typedef short bf16x8 __attribute__((ext_vector_type(8)));
typedef float f32x4 __attribute__((ext_vector_type(4)));
typedef unsigned u32x4 __attribute__((ext_vector_type(4)));
constexpr int BM = 256, BK = 64, HALF = 128, HTB = HALF * BK * 2  , STAGE_BYTES = 8 * HTB, NXCD = 8, WGM = 8;

__host__ __device__ __forceinline__ int lds_byte(int r, int c) { const int st = (r >> 4) * 2 + (c >> 5), rr = r & 15, cc = c & 31, ob = rr * 64 + cc * 2; return st * 1024 + (ob ^ (((ob >> 9) & 1) << 5)); }
__host__ __device__ __forceinline__ void stage_rc(int b, int& R, int& C) { const int st = b / 1024, sb = b % 1024, swz = sb ^ (((sb >> 9) & 1) << 5); R = (st >> 1) * 16 + swz / 64; C = (st & 1) * 32 + (swz % 64) / 2; }
__host__ __device__ __forceinline__ int perm32(int rho) { const int n = rho >> 4, i = rho & 15; return 8 * (i >> 2) + 4 * n + (i & 3); }

struct Unit { int pm, pn; };
struct Gemm { const bf16_t* A; const bf16_t* Bt; int M, N, K; };

struct StaticOrder {
    int nM, nN, nwg, G, c;
    __host__ __device__ void init(int M, int N, int G_, int c_) { nM = M / BM; nN = N / BM; nwg = nM * nN; G = G_; c = c_; }
    __host__ __device__ bool next(int i, Unit& u) const {
        const long L = (long)i * G + c; if (L >= nwg) return false;
        int wgid = (int)L; { const int q = nwg / NXCD, r = nwg % NXCD, xcd = wgid % NXCD, off = wgid / NXCD; wgid = (xcd < r ? xcd * (q + 1) : r * (q + 1) + (xcd - r) * q) + off; }
        const int nig = WGM * nN, gid = wgid / nig, fm = gid * WGM, gsz = (nM - fm) < WGM ? (nM - fm) : WGM;
        u.pm = fm + ((wgid % nig) % gsz); u.pn = (wgid % nig) / gsz; return true;
    }
    __device__ __forceinline__ void a_ready(const Unit&) const {}
    __device__ __forceinline__ void done(const Unit&) const {}
};

typedef float f32x2_t __attribute__((ext_vector_type(2))); typedef __bf16 bf16x2_t __attribute__((ext_vector_type(2)));
__device__ __forceinline__ unsigned cvt_pk_bf16(float lo, float hi) { f32x2_t v = {lo, hi}; bf16x2_t b = __builtin_convertvector(v, bf16x2_t); return __builtin_bit_cast(unsigned, b); }
typedef float f32x2 __attribute__((ext_vector_type(2)));
struct EpiBf16 {
    static constexpr bool PERM = true, AFTER_DRAIN = false;
    bf16_t* O; int ldc;
    __device__ __forceinline__ void operator()(const f32x4 (&acc)[2][2][4][2], const Unit& u, int wr, int wc, int fr, int fq) const {
        const int row0 = u.pm * BM + wr * 64 + fr, col0 = u.pn * BM + wc * 32 + 8 * fq;
#pragma unroll
        for (int ai = 0; ai < 2; ++ai)
#pragma unroll
            for (int m = 0; m < 4; ++m) { bf16_t* rowp = O + (size_t)(row0 + ai * HALF + m * 16) * ldc + col0;
#pragma unroll
                for (int bj = 0; bj < 2; ++bj) { const f32x4 v0 = acc[ai][bj][m][0], v1 = acc[ai][bj][m][1];
                    u32x4 w; w.x = cvt_pk_bf16(v0[0], v0[1]); w.y = cvt_pk_bf16(v0[2], v0[3]); w.z = cvt_pk_bf16(v1[0], v1[1]); w.w = cvt_pk_bf16(v1[2], v1[3]);
                    *(u32x4*)(rowp + bj * HALF) = w; } }
    }
};
struct EpiResBf16 {
    static constexpr bool PERM = true, AFTER_DRAIN = false;
    const float* base; bf16_t* O; int ldc;
    __device__ __forceinline__ void operator()(const f32x4 (&acc)[2][2][4][2], const Unit& u, int wr, int wc, int fr, int fq) const {
        const int row0 = u.pm * BM + wr * 64 + fr, col0 = u.pn * BM + wc * 32 + 8 * fq;
#pragma unroll
        for (int ai = 0; ai < 2; ++ai)
#pragma unroll
            for (int m = 0; m < 4; ++m) { const size_t off = (size_t)(row0 + ai * HALF + m * 16) * ldc + col0;
#pragma unroll
                for (int bj = 0; bj < 2; ++bj) { const f32x4 b0 = *(const f32x4*)(base + off + bj * HALF), b1 = *(const f32x4*)(base + off + bj * HALF + 4);
                    const f32x4 v0 = acc[ai][bj][m][0] + b0, v1 = acc[ai][bj][m][1] + b1;
                    u32x4 w; w.x = cvt_pk_bf16(v0[0], v0[1]); w.y = cvt_pk_bf16(v0[2], v0[3]); w.z = cvt_pk_bf16(v1[0], v1[1]); w.w = cvt_pk_bf16(v1[2], v1[3]);
                    *(u32x4*)(O + off + bj * HALF) = w; }
                asm volatile("" ::: "memory"); }
    }
};
__device__ __forceinline__ unsigned pk4_fp8(float a, float b, float c, float d) { int w = 0; w = __builtin_amdgcn_cvt_pk_fp8_f32(a, b, w, false); w = __builtin_amdgcn_cvt_pk_fp8_f32(c, d, w, true); return (unsigned)w; }
struct EpiSwiglu8 {
    static constexpr bool PERM = true, AFTER_DRAIN = false;
    unsigned char* act; const float* gu_b;
    __device__ __forceinline__ void with_bias(const f32x4 (&acc)[2][2][4][2], const Unit& u, int wr, int wc, int fr, int fq, const float (&b)[16]) const {
        typedef float f2 __attribute__((ext_vector_type(2)));
        const int j = u.pn & 7;
        const int row0 = u.pm * BM + wr * 64 + fr, a0 = j * 128 + wc * 32 + 8 * fq;
        const f2 bg[4] = {{b[0], b[2]}, {b[4], b[6]}, {b[8], b[10]}, {b[12], b[14]}};
        const f2 bl[4] = {{b[1] + 1.f, b[3] + 1.f}, {b[5] + 1.f, b[7] + 1.f}, {b[9] + 1.f, b[11] + 1.f}, {b[13] + 1.f, b[15] + 1.f}};
        const f2 sc = {0.03125f, 0.03125f}, one = {1.f, 1.f}, c1 = {-1.702f * 1.4426950408889634f, -1.702f * 1.4426950408889634f};
#pragma unroll
        for (int ai = 0; ai < 2; ++ai)
#pragma unroll
            for (int m = 0; m < 4; ++m) {
                f2 o[4];
#pragma unroll
                for (int p = 0; p < 4; ++p) {
                    const int n = p >> 1, i = (p & 1) * 2;
                    f2 hg = (f2){acc[ai][0][m][n][i], acc[ai][0][m][n][i + 1]} * sc + bg[p];
                    f2 hl = (f2){acc[ai][1][m][n][i], acc[ai][1][m][n][i + 1]} * sc + bl[p];
                    hg.x = fminf(hg.x, 7.f); hg.y = fminf(hg.y, 7.f);
                    hl.x = __builtin_amdgcn_fmed3f(hl.x, -6.f, 8.f); hl.y = __builtin_amdgcn_fmed3f(hl.y, -6.f, 8.f);
                    const f2 t = hg * c1;
                    f2 ex; ex.x = __builtin_amdgcn_exp2f(t.x); ex.y = __builtin_amdgcn_exp2f(t.y);
                    const f2 d = ex + one;
                    f2 r; r.x = __builtin_amdgcn_rcpf(d.x); r.y = __builtin_amdgcn_rcpf(d.y);
                    o[p] = (hg * r) * hl;
                }
                typedef unsigned u32x2 __attribute__((ext_vector_type(2)));
                *(u32x2*)(act + (size_t)(row0 + ai * HALF + m * 16) * 1024 + a0) = (u32x2){pk4_fp8(o[0].x, o[0].y, o[1].x, o[1].y), pk4_fp8(o[2].x, o[2].y, o[3].x, o[3].y)};
            }
    }
};
struct EpiDown8 {
    static constexpr bool PERM = true, AFTER_DRAIN = false;
    unsigned char* yb; const float* dn_b; const float* gate;
    __device__ __forceinline__ void with_ops(const f32x4 (&acc)[2][2][4][2], const Unit& u, int wr, int wc, int fr, int fq, const float (&b)[16], const float (&g)[8]) const {
        const int j = u.pn & 3;
        const int row0 = u.pm * BM + wr * 64 + fr, col0 = j * 256 + wc * 64 + 16 * fq;
#pragma unroll
        for (int ai = 0; ai < 2; ++ai)
#pragma unroll
            for (int m = 0; m < 4; ++m) { const int row = row0 + ai * HALF + m * 16; const float gt = g[4 * ai + m], gb = gt * 32.f;
                u32x4 w;
#pragma unroll
                for (int bj = 0; bj < 2; ++bj) {
                    const f32x4 bv0 = {b[8 * bj + 0], b[8 * bj + 1], b[8 * bj + 2], b[8 * bj + 3]}, bv1 = {b[8 * bj + 4], b[8 * bj + 5], b[8 * bj + 6], b[8 * bj + 7]};
                    const f32x4 v0 = acc[ai][bj][m][0] * gt + bv0 * gb, v1 = acc[ai][bj][m][1] * gt + bv1 * gb;
                    w[2 * bj] = pk4_fp8(v0[0], v0[1], v0[2], v0[3]); w[2 * bj + 1] = pk4_fp8(v1[0], v1[1], v1[2], v1[3]); }
                *(u32x4*)(yb + (size_t)row * 1024 + col0) = w; }
    }
};
struct MoeOrder {
    const PG8_LAS int* tile_e; int nt, NT, c;
    __device__ __forceinline__ bool next(int i, Unit& u) const {
        const int v = c & 7, s = c >> 3;
        const int t0 = (v * nt) >> 3, t1 = ((v + 1) * nt) >> 3, n = t1 - t0;
        const int q = i * 32 + s;
        if (q >= n * NT) return false;
        const int gl = 1 * NT, g = q / gl, r = q - g * gl, fm = t0 + 1 * g, gsz = (t1 - fm) < 1 ? (t1 - fm) : 1;
        const int j = r / gsz, tile = fm + (r - j * gsz);
        u.pm = tile; u.pn = __builtin_amdgcn_readfirstlane(tile_e[tile]) * NT + j; return true;
    }
    __device__ __forceinline__ void a_ready(const Unit&) const {}
    __device__ __forceinline__ void done(const Unit&) const {}
};

constexpr int RT_LDS = 131072 + 8192 + 16384;
constexpr int EPI_LDS = 131072 + 8192;
template <class Epi> struct EpiPre {
    __device__ __forceinline__ void load(const Epi&, const Unit&, int, int, int, PG8_LAS unsigned char*, int) {}
    __device__ __forceinline__ void load_next(const Epi&, const Unit&, int, int, int, PG8_LAS unsigned char*, int) {}
    __device__ __forceinline__ void run(const Epi& E, const f32x4 (&acc)[2][2][4][2], const Unit& u, int wr, int wc, int fr, int fq, PG8_LAS unsigned char*, int) { E(acc, u, wr, wc, fr, fq); }
};
__device__ __forceinline__ void dma4(const float* g, PG8_LAS unsigned char* l) { __builtin_amdgcn_global_load_lds((const unsigned*)g, (PG8_LAS unsigned*)l, 4, 0, 0); }
template <> struct EpiPre<EpiSwiglu8> {
    int par;
    __device__ __forceinline__ void fetch(const EpiSwiglu8& E, const Unit& u, int wc, int lane, PG8_LAS unsigned char* lds, int wid, int p) const {
        const int e = u.pn >> 3, j = u.pn & 7;
        dma4(E.gu_b + (size_t)e * 2048 + 2 * (j * 128 + wc * 32 + 8 * (lane >> 4)) + (lane & 15), lds + EPI_LDS + (p * 8 + wid) * 1024);
    }
    __device__ __forceinline__ void load(const EpiSwiglu8& E, const Unit& u, int, int wc, int lane, PG8_LAS unsigned char* lds, int wid) { par = 0; fetch(E, u, wc, lane, lds, wid, 0); }
    __device__ __forceinline__ void load_next(const EpiSwiglu8& E, const Unit& u, int, int wc, int lane, PG8_LAS unsigned char* lds, int wid) { fetch(E, u, wc, lane, lds, wid, par ^ 1); }
    __device__ __forceinline__ void run(const EpiSwiglu8& E, const f32x4 (&acc)[2][2][4][2], const Unit& u, int wr, int wc, int fr, int fq, PG8_LAS unsigned char* lds, int wid) {
        const PG8_LAS f32x4* s = (const PG8_LAS f32x4*)(lds + EPI_LDS + (par * 8 + wid) * 1024 + fq * 64);
        const f32x4 b0 = s[0], b1 = s[1], b2 = s[2], b3 = s[3];
        const float b[16] = {b0[0], b0[1], b0[2], b0[3], b1[0], b1[1], b1[2], b1[3], b2[0], b2[1], b2[2], b2[3], b3[0], b3[1], b3[2], b3[3]};
        E.with_bias(acc, u, wr, wc, fr, fq, b);
        par ^= 1;
    }
};
template <> struct EpiPre<EpiDown8> {
    int par;
    __device__ __forceinline__ void fetch(const EpiDown8& E, const Unit& u, int wr, int wc, int lane, PG8_LAS unsigned char* lds, int wid, int p) const {
        const int e = u.pn >> 2, j = u.pn & 3; PG8_LAS unsigned char* slot = lds + EPI_LDS + (p * 8 + wid) * 1024;
        dma4(E.dn_b + (size_t)e * 1024 + j * 256 + wc * 64 + lane, slot);
#pragma unroll
        for (int k = 0; k < 2; ++k) { const int am = (lane >> 4) + 4 * k; dma4(E.gate + u.pm * BM + wr * 64 + (lane & 15) + (am >> 2) * HALF + (am & 3) * 16, slot + 256 + 256 * k); }
    }
    __device__ __forceinline__ void load(const EpiDown8& E, const Unit& u, int wr, int wc, int lane, PG8_LAS unsigned char* lds, int wid) { par = 0; fetch(E, u, wr, wc, lane, lds, wid, 0); }
    __device__ __forceinline__ void load_next(const EpiDown8& E, const Unit& u, int wr, int wc, int lane, PG8_LAS unsigned char* lds, int wid) { fetch(E, u, wr, wc, lane, lds, wid, par ^ 1); }
    __device__ __forceinline__ void run(const EpiDown8& E, const f32x4 (&acc)[2][2][4][2], const Unit& u, int wr, int wc, int fr, int fq, PG8_LAS unsigned char* lds, int wid) {
        const PG8_LAS unsigned char* slot = lds + EPI_LDS + (par * 8 + wid) * 1024;
        const PG8_LAS f32x4* s = (const PG8_LAS f32x4*)(slot + fq * 64);
        const f32x4 b0 = s[0], b1 = s[1], b2 = s[2], b3 = s[3];
        const float b[16] = {b0[0], b0[1], b0[2], b0[3], b1[0], b1[1], b1[2], b1[3], b2[0], b2[1], b2[2], b2[3], b3[0], b3[1], b3[2], b3[3]};
        float g[8];
#pragma unroll
        for (int am = 0; am < 8; ++am) g[am] = *(const PG8_LAS float*)(slot + 256 + 256 * (am >> 2) + (fr + 16 * (am & 3)) * 4);
        E.with_ops(acc, u, wr, wc, fr, fq, b, g);
        par ^= 1;
    }
};
typedef int v8i32 __attribute__((ext_vector_type(8)));
typedef int v4i32 __attribute__((ext_vector_type(4)));
__device__ __forceinline__ v8i32 ld8(const PG8_LAS unsigned char* p, int kst) { const v4i32 a = *(const PG8_LAS v4i32*)p, b = *(const PG8_LAS v4i32*)(p + kst); return __builtin_shufflevector(a, b, 0, 1, 2, 3, 4, 5, 6, 7); }
__device__ __forceinline__ bf16x8 flo(const v8i32& f) { return __builtin_bit_cast(bf16x8, (v4i32)__builtin_shufflevector(f, f, 0, 1, 2, 3)); }
__device__ __forceinline__ bf16x8 fhi(const v8i32& f) { return __builtin_bit_cast(bf16x8, (v4i32)__builtin_shufflevector(f, f, 4, 5, 6, 7)); }
template <class Epi, class Sched, bool ALIGN_EPI = false, bool SP2 = false, bool FP8 = false, bool GATHER = false>
__device__ __forceinline__ void gemm_phase(PG8_LAS unsigned char* lds, const Gemm g, const Sched& S, const Epi& E, const int wid_in, const int* rowtok = nullptr) {
    static_assert(!GATHER || SP2, "gather is wired into the SP2 schedule only");
    int lane = hw_lane_id(); asm volatile("" : "+v"(lane));
    const int wid = wid_in, tid = wid * 64 + lane, wr = wid >> 2, wc = wid & 3, fr = lane & 15, fq = lane >> 4;
    int K = g.K; asm volatile("" : "+s"(K));
    const int nt = K / BK;
    unsigned voffA[2], voffB[2];
#pragma unroll
    for (int i = 0; i < 2; ++i) { int R, C; stage_rc(tid * 16 + i * 8192, R, C); const int Rb = Epi::PERM ? ((R & ~31) + perm32(R & 31)) : R;
        voffA[i] = (unsigned)(R * K + C) * 2u; voffB[i] = (unsigned)(Rb * K + C) * 2u; }
    unsigned gA[4] = {0u, 0u, 0u, 0u};
    const unsigned gcol = voffA[0] - (unsigned)(((wid >> 1) * 16 + (lane >> 2)) * K) * 2u;
    PG8_LAS unsigned char* rts = lds + RT_LDS + wid * 256;
    const size_t kstep = (size_t)(BK * 2);
    const size_t hstep = (size_t)HALF * K * 2;
    const size_t tstep = 2 * hstep;
    const unsigned ldsw = (unsigned)wid * 1024u;
    const int aoff = FP8 ? lds_byte(wr * 64 + fr, fq * 16) : lds_byte(wr * 64 + fr, fq * 8), boff = FP8 ? lds_byte(wc * 32 + fr, fq * 16) : lds_byte(wc * 32 + fr, fq * 8);
    constexpr int KST = FP8 ? 16 : 1024;
    int scl = 0x7F7F7F7F; asm volatile("" : "+v"(scl));
#define PG8_SA(b, h) (((b) * 2 + (h)) * HTB)
#define PG8_SB(b, h) ((4 + (b) * 2 + (h)) * HTB)
#define PG8_STAGE(bufoff, gbase, voff) do { _Pragma("unroll") for (int _i = 0; _i < 2; ++_i) \
        __builtin_amdgcn_global_load_lds((const unsigned*)((const char*)(gbase) + (voff)[_i]), (PG8_LAS unsigned*)(lds + (bufoff) + ldsw + _i * 8192), 16, 0, 0); } while (0)
#define PG8_STAGE_A(bufoff, gbase, h) do { if constexpr (GATHER) { _Pragma("unroll") for (int _i = 0; _i < 2; ++_i) \
        __builtin_amdgcn_global_load_lds((const unsigned*)((const char*)(gbase) + gA[2 * (h) + _i]), (PG8_LAS unsigned*)(lds + (bufoff) + ldsw + _i * 8192), 16, 0, 0); } \
        else PG8_STAGE(bufoff, (gbase) + (h) * hstep, voffA); } while (0)
#define PG8_LDA(dst, b, h) do { _Pragma("unroll") for (int m = 0; m < 4; ++m) dst[m] = ld8(lds + PG8_SA(b, h) + aoff + m * 2048, KST); } while (0)
#define PG8_LDB(dst, b, h) do { _Pragma("unroll") for (int n = 0; n < 2; ++n) dst[n] = ld8(lds + PG8_SB(b, h) + boff + n * 2048, KST); } while (0)
#define PG8_MMA(ai, bj, At, Bt) do { __builtin_amdgcn_s_setprio(1); if constexpr (FP8) { _Pragma("unroll") for (int m = 0; m < 4; ++m) _Pragma("unroll") for (int n = 0; n < 2; ++n) \
        asm volatile("v_mfma_scale_f32_16x16x128_f8f6f4 %0, %1, %2, %0, %3, %3 op_sel_hi:[0,0,0]" : "+v"(acc[ai][bj][m][n]) : "v"(Bt[n]), "v"(At[m]), "v"(scl)); } else { \
        _Pragma("unroll") for (int m = 0; m < 4; ++m) _Pragma("unroll") for (int n = 0; n < 2; ++n) { \
        acc[ai][bj][m][n] = __builtin_amdgcn_mfma_f32_16x16x32_bf16(flo(Bt[n]), flo(At[m]), acc[ai][bj][m][n], 0, 0, 0); \
        acc[ai][bj][m][n] = __builtin_amdgcn_mfma_f32_16x16x32_bf16(fhi(Bt[n]), fhi(At[m]), acc[ai][bj][m][n], 0, 0, 0); } } __builtin_amdgcn_s_setprio(0); } while (0)
#define PG8_WAIT_V(n) asm volatile("s_waitcnt vmcnt(" #n ")" ::: "memory")
#define PG8_WAIT_L(n) asm volatile("s_waitcnt lgkmcnt(" #n ")" ::: "memory")
#define PG8_BAR __builtin_amdgcn_s_barrier()
#define PG8_SCHED __builtin_amdgcn_sched_barrier(0)
    Unit cur, nxt; int ui = 0;
    if (!S.next(0, cur)) return;
    f32x4 acc[2][2][4][2];
#pragma unroll
    for (int a = 0; a < 2; ++a)
#pragma unroll
        for (int b = 0; b < 2; ++b)
#pragma unroll
            for (int m = 0; m < 4; ++m)
#pragma unroll
                for (int n = 0; n < 2; ++n) acc[a][b][m][n] = (f32x4){0.f, 0.f, 0.f, 0.f};
    v8i32 At[4], B0[2], B1[2];
    const char* cA = (const char*)g.A + (GATHER ? (size_t)0 : (size_t)cur.pm * tstep); const char* cB = (const char*)g.Bt + (size_t)cur.pn * tstep;
    S.a_ready(cur);
    if constexpr (GATHER) { const int* rp = rowtok + cur.pm * 256 + (wid >> 1) * 16 + (lane >> 2);
        _Pragma("unroll") for (int q = 0; q < 4; ++q) gA[q] = (unsigned)rp[64 * q] * (unsigned)(K * 2) + gcol; }
    EpiPre<Epi> pre; pre.load(E, cur, wr, wc, lane, lds, wid);
    if constexpr (SP2) {
        PG8_STAGE(PG8_SB(0, 0), cB, voffB); PG8_STAGE(PG8_SB(0, 1), cB + hstep, voffB); PG8_STAGE_A(PG8_SA(0, 0), cA, 0); PG8_STAGE_A(PG8_SA(0, 1), cA, 1);
        if (wr == 1) PG8_BAR;
        PG8_WAIT_V(2); PG8_BAR;
        PG8_STAGE(PG8_SB(1, 0), cB + kstep, voffB); PG8_STAGE_A(PG8_SA(1, 0), cA + kstep, 0); PG8_STAGE(PG8_SB(1, 1), cB + hstep + kstep, voffB);
        PG8_WAIT_V(6); PG8_BAR;
    } else {
        PG8_STAGE(PG8_SB(0, 0), cB, voffB); PG8_STAGE(PG8_SA(0, 0), cA, voffA); PG8_STAGE(PG8_SB(0, 1), cB + hstep, voffB); PG8_STAGE(PG8_SA(0, 1), cA + hstep, voffA);
        if (wr == 1) PG8_BAR;
        PG8_WAIT_V(4); PG8_BAR;
        PG8_STAGE(PG8_SB(1, 0), cB + kstep, voffB); PG8_STAGE(PG8_SA(1, 0), cA + kstep, voffA); PG8_STAGE(PG8_SB(1, 1), cB + hstep + kstep, voffB);
        PG8_WAIT_V(6); PG8_BAR;
    }
    for (;;) {
        const bool has_next = S.next(ui + 1, nxt);
        const char* nA = has_next ? (const char*)g.A + (GATHER ? (size_t)0 : (size_t)nxt.pm * tstep) : cA; const char* nB = has_next ? (const char*)g.Bt + (size_t)nxt.pn * tstep : cB;
#pragma unroll 1
        for (int t = 0; t < nt; t += 2) {
            const bool last = (t == nt - 2);
            const char* a1 = cA + (size_t)(t + 1) * kstep;
            const char* a2 = last ? nA : cA + (size_t)(t + 2) * kstep; const char* b2 = last ? nB : cB + (size_t)(t + 2) * kstep;
            const char* a3 = a2 + kstep; const char* b3 = b2 + kstep;
            if (last && has_next) { S.a_ready(nxt); pre.load_next(E, nxt, wr, wc, lane, lds, wid); }
            if constexpr (GATHER) { if (t == 0 && has_next) dma4((const float*)(rowtok + nxt.pm * 256 + (wid >> 1) * 16 + (lane >> 2) + 64 * (lane & 3)), rts); }
            if constexpr (SP2) {
            PG8_LDB(B0, 0, 0); PG8_LDB(B1, 0, 1); PG8_SCHED; PG8_LDA(At, 0, 0); PG8_STAGE_A(PG8_SA(1, 1), a1, 1);
            if constexpr (GATHER) { if (last && has_next) { asm volatile("" ::: "memory");
                const u32x4 rt = *(const PG8_LAS u32x4*)(rts + 16 * (lane >> 2)); _Pragma("unroll") for (int q = 0; q < 4; ++q) gA[q] = rt[q] * (unsigned)(K * 2) + gcol; } }
            PG8_WAIT_V(8); PG8_WAIT_L(0); PG8_BAR; PG8_MMA(0, 0, At, B0); PG8_MMA(0, 1, At, B1); PG8_BAR; PG8_SCHED;
            PG8_LDA(At, 0, 1); PG8_STAGE(PG8_SB(0, 0), b2, voffB); PG8_STAGE(PG8_SB(0, 1), b2 + hstep, voffB); PG8_STAGE_A(PG8_SA(0, 0), a2, 0);
            PG8_WAIT_V(8); PG8_WAIT_L(0); PG8_BAR; PG8_MMA(1, 0, At, B0); PG8_MMA(1, 1, At, B1); PG8_BAR; PG8_SCHED;
            PG8_LDB(B0, 1, 0); PG8_LDB(B1, 1, 1); PG8_SCHED; PG8_LDA(At, 1, 0); PG8_STAGE_A(PG8_SA(0, 1), a2, 1);
            PG8_WAIT_V(8); PG8_WAIT_L(0); PG8_BAR; PG8_MMA(0, 0, At, B0); PG8_MMA(0, 1, At, B1); PG8_BAR; PG8_SCHED;
            PG8_LDA(At, 1, 1); PG8_STAGE(PG8_SB(1, 0), b3, voffB); PG8_STAGE(PG8_SB(1, 1), b3 + hstep, voffB); PG8_STAGE_A(PG8_SA(1, 0), a3, 0);
            PG8_WAIT_V(8); PG8_WAIT_L(0); PG8_BAR; PG8_MMA(1, 0, At, B0); PG8_MMA(1, 1, At, B1); PG8_BAR; PG8_SCHED;
            } else {
            PG8_LDB(B0, 0, 0); PG8_SCHED; PG8_LDA(At, 0, 0); PG8_STAGE(PG8_SA(1, 1), a1 + hstep, voffA);
            PG8_WAIT_L(8); PG8_BAR; PG8_WAIT_L(0); PG8_MMA(0, 0, At, B0); PG8_BAR; PG8_SCHED;
            PG8_LDB(B1, 0, 1); PG8_STAGE(PG8_SB(0, 0), b2, voffB);
            PG8_BAR; PG8_WAIT_L(0); PG8_MMA(0, 1, At, B1); PG8_BAR;
            PG8_LDA(At, 0, 1); PG8_STAGE(PG8_SA(0, 0), a2, voffA);
            PG8_BAR; PG8_WAIT_L(0); PG8_MMA(1, 0, At, B0); PG8_BAR; PG8_SCHED;
            PG8_STAGE(PG8_SB(0, 1), b2 + hstep, voffB);
            PG8_WAIT_V(6); PG8_BAR; PG8_MMA(1, 1, At, B1); PG8_BAR;
            PG8_LDB(B0, 1, 0); PG8_SCHED; PG8_LDA(At, 1, 0); PG8_STAGE(PG8_SA(0, 1), a2 + hstep, voffA);
            PG8_WAIT_L(8); PG8_BAR; PG8_WAIT_L(0); PG8_MMA(0, 0, At, B0); PG8_BAR; PG8_SCHED;
            PG8_LDB(B1, 1, 1); PG8_STAGE(PG8_SB(1, 0), b3, voffB);
            PG8_BAR; PG8_WAIT_L(0); PG8_MMA(0, 1, At, B1); PG8_BAR;
            PG8_LDA(At, 1, 1); PG8_STAGE(PG8_SA(1, 0), a3, voffA);
            PG8_BAR; PG8_WAIT_L(0); PG8_MMA(1, 0, At, B0); PG8_BAR; PG8_SCHED;
            PG8_STAGE(PG8_SB(1, 1), b3 + hstep, voffB);
            PG8_WAIT_V(6); PG8_BAR; PG8_MMA(1, 1, At, B1); PG8_BAR;
            }
        }
        if constexpr (ALIGN_EPI) { if (wr == 0) PG8_BAR; }
        if constexpr (FP8) { asm volatile("s_nop 15\n\ts_nop 15" ::: "memory"); }
        if constexpr (!Epi::AFTER_DRAIN) { pre.run(E, acc, cur, wr, wc, fr, fq, lds, wid); S.done(cur); }
        if (!has_next) break;
#pragma unroll
        for (int a = 0; a < 2; ++a)
#pragma unroll
            for (int b = 0; b < 2; ++b)
#pragma unroll
                for (int m = 0; m < 4; ++m)
#pragma unroll
                    for (int n = 0; n < 2; ++n) acc[a][b][m][n] = (f32x4){0.f, 0.f, 0.f, 0.f};
        cur = nxt; cA = nA; cB = nB; ++ui;
        if constexpr (ALIGN_EPI) { if (wr == 1) PG8_BAR; }
    }
    PG8_WAIT_V(0);
    if constexpr (!ALIGN_EPI) { if (wr == 0) PG8_BAR; }
    PG8_BAR;
    if constexpr (Epi::AFTER_DRAIN) { E.fused(acc, cur, wr, wc, fr, fq, lds, wid, lane); S.done(cur); }
#undef PG8_SA
#undef PG8_SB
#undef PG8_STAGE
#undef PG8_STAGE_A
#undef PG8_LDA
#undef PG8_LDB
#undef PG8_MMA
#undef PG8_WAIT_V
#undef PG8_WAIT_L
#undef PG8_BAR
#undef PG8_SCHED
}
}

namespace rk {
typedef unsigned short bf16_t;
typedef short bf16x8 __attribute__((ext_vector_type(8)));
typedef float f32x16 __attribute__((ext_vector_type(16)));
typedef float f32x4 __attribute__((ext_vector_type(4)));
typedef unsigned v4u __attribute__((ext_vector_type(4)));
typedef unsigned v2u __attribute__((ext_vector_type(2)));
#define RK_LAS __attribute__((address_space(3)))
constexpr int PB = 72, PF = 65;
constexpr int L_TW = 0, L_DA = 9216, L_F1 = 18432, L_F2 = 35072, L_F3 = 51712, L_BF = 68352, BFB = 9216;
constexpr int L_AP = L_BF, L_RP = L_BF + BFB, L_BM = L_BF + 2 * BFB, L_KM = L_BF + 3 * BFB, L_BHT = L_BF + 4 * BFB, L_KHT = L_BF + 5 * BFB, L_VT = L_BF + 6 * BFB,
              L_LAK = L_BF + 7 * BFB, L_LRB = L_BF + 8 * BFB, L_LRK = L_BF + 9 * BFB, L_END = L_BF + 10 * BFB;
constexpr int L_WT = L_BM, L_U0 = L_KM, L_GT = L_LRK;
constexpr int L_TI = L_F2, L_SCR = L_F2 + 4352;
constexpr int R1_LDS = L_END;
constexpr int P_LD = 3328, C_R = 1536, C_K = 2048, C_V = 2560, C_DW = 3072, C_DA = 3136, C_DG = 3200;
constexpr int UNIT_BYTES = 32768;

typedef float f32x2_t __attribute__((ext_vector_type(2))); typedef __bf16 bf16x2_t __attribute__((ext_vector_type(2)));
__device__ __forceinline__ unsigned cvtpk(float lo, float hi) { f32x2_t v = {lo, hi}; bf16x2_t b = __builtin_convertvector(v, bf16x2_t); return __builtin_bit_cast(unsigned, b); }
__device__ __forceinline__ unsigned short f2b(float f) { return (unsigned short)(cvtpk(f, 0.f) & 0xffffu); }
__device__ __forceinline__ float b2f(unsigned short b) { return __builtin_bit_cast(float, (unsigned)b << 16); }
__device__ __forceinline__ float blo(unsigned u) { return __builtin_bit_cast(float, u << 16); }
__device__ __forceinline__ float bhi(unsigned u) { return __builtin_bit_cast(float, u & 0xffff0000u); }
__device__ __forceinline__ int drow(int q, int hh) { return (q & 3) + 8 * (q >> 2) + 4 * hh; }
__device__ __forceinline__ bf16x8 pack8(const f32x16& d, int s) {
    v4u w; w.x = cvtpk(d[8 * s + 0], d[8 * s + 1]); w.y = cvtpk(d[8 * s + 2], d[8 * s + 3]); w.z = cvtpk(d[8 * s + 4], d[8 * s + 5]); w.w = cvtpk(d[8 * s + 6], d[8 * s + 7]);
    return __builtin_bit_cast(bf16x8, w);
}
__device__ __forceinline__ f32x16 zero16() { f32x16 z;
#pragma unroll
    for (int i = 0; i < 16; ++i) z[i] = 0.f; return z; }
__device__ __forceinline__ bf16x8 ldsfrag(const RK_LAS unsigned char* base, int row, int kofs) { return *(const RK_LAS bf16x8*)(base + (row * PB + kofs) * 2); }
__device__ __forceinline__ void store_dfrag(unsigned char* gbase, int lane, const f32x16& d) {
    v4u w0, w1; w0.x = cvtpk(d[0], d[1]); w0.y = cvtpk(d[2], d[3]); w0.z = cvtpk(d[4], d[5]); w0.w = cvtpk(d[6], d[7]);
    w1.x = cvtpk(d[8], d[9]); w1.y = cvtpk(d[10], d[11]); w1.z = cvtpk(d[12], d[13]); w1.w = cvtpk(d[14], d[15]);
    v4u* p = (v4u*)(gbase + lane * 32); p[0] = w0; p[1] = w1;
}
__device__ __forceinline__ float dppf(float v, const int ctrl_tag) {
    const int b = __builtin_bit_cast(int, v);
    int r;
    if (ctrl_tag == 0) r = __builtin_amdgcn_mov_dpp(b, 0xB1, 0xF, 0xF, true);
    else if (ctrl_tag == 1) r = __builtin_amdgcn_mov_dpp(b, 0x4E, 0xF, 0xF, true);
    else if (ctrl_tag == 2) r = __builtin_amdgcn_mov_dpp(b, 0x141, 0xF, 0xF, true);
    else r = __builtin_amdgcn_mov_dpp(b, 0x140, 0xF, 0xF, true);
    return __builtin_bit_cast(float, r);
}
__device__ __forceinline__ float wsum(float v) {
    v += dppf(v, 0); v += dppf(v, 1); v += dppf(v, 2); v += dppf(v, 3);
    { const unsigned u = __builtin_bit_cast(unsigned, v); auto r = __builtin_amdgcn_permlane16_swap(u, u, false, false); v = __builtin_bit_cast(float, (unsigned)r[0]) + __builtin_bit_cast(float, (unsigned)r[1]); }
    { const unsigned u = __builtin_bit_cast(unsigned, v); auto r = __builtin_amdgcn_permlane32_swap(u, u, false, false); v = __builtin_bit_cast(float, (unsigned)r[0]) + __builtin_bit_cast(float, (unsigned)r[1]); }
    return v;
}
#define RK_SYNC() __syncthreads()


struct R1Args { const bf16_t* P; const float *mu, *w0, *a0, *k_k, *k_a, *r_k; const bf16_t *WdT, *WiT; unsigned char* units; float* gam; float* bon; float* dump; };

__device__ __forceinline__ void r1_block(const R1Args& A, RK_LAS unsigned char* lds, int bc, const int wid_in) {
    const int lane = hw_lane_id(), w = wid_in, tid = w * 64 + lane, r32 = lane & 31, hh = lane >> 5;
    const int b = bc >> 7, c = bc & 127, row0 = b * 8192 + c * 64;
    RK_LAS float* F1 = (RK_LAS float*)(lds + L_F1); RK_LAS float* F2 = (RK_LAS float*)(lds + L_F2); RK_LAS float* F3 = (RK_LAS float*)(lds + L_F3);
    {
        const int t = tid >> 3, cg = tid & 7, col = (cg & 3) * 16;
        const bf16_t* pc = A.P + (size_t)(row0 + t) * P_LD + C_DW + cg * 16;
        const bool hp = (t > 0 || c > 0); const int pofs = hp ? -P_LD : 0; const v4u zero4 = {0, 0, 0, 0};
        v4u c0 = *(const v4u*)pc, c1 = *(const v4u*)(pc + 8), p0 = *(const v4u*)(pc + pofs), p1 = *(const v4u*)(pc + pofs + 8);
        p0 = hp ? p0 : zero4; p1 = hp ? p1 : zero4;
        const unsigned cu[8] = {c0.x, c0.y, c0.z, c0.w, c1.x, c1.y, c1.z, c1.w}, pu[8] = {p0.x, p0.y, p0.z, p0.w, p1.x, p1.y, p1.z, p1.w};
        const float* mup = A.mu + (C_DW - C_R) + cg * 16;
        unsigned o[8];
#pragma unroll
        for (int i = 0; i < 8; ++i) {
            float x0 = blo(cu[i]), x1 = bhi(cu[i]); const float q0 = blo(pu[i]), q1 = bhi(pu[i]);
            x0 = x0 + (q0 - x0) * mup[2 * i]; x1 = x1 + (q1 - x1) * mup[2 * i + 1];
            if (cg < 4) { x0 = 1.f - 2.f * __builtin_amdgcn_rcpf(1.f + __expf(2.f * x0)); x1 = 1.f - 2.f * __builtin_amdgcn_rcpf(1.f + __expf(2.f * x1)); }
            o[i] = cvtpk(x0, x1);
        }
        RK_LAS v4u* dst = (RK_LAS v4u*)(lds + (cg < 4 ? L_TW : L_DA) + (t * PB + col) * 2);
        dst[0] = (v4u){o[0], o[1], o[2], o[3]}; dst[1] = (v4u){o[4], o[5], o[6], o[7]};
    }
    RK_SYNC();
    struct HeadIn { bf16_t r[8], k[8], v[8], pr, pk, pv; float w0c, a0c, kkc, kac, rkc, mur, muk, muv; bf16x8 bf[4]; };
    auto load_head = [&](HeadIn& H, int h) {
        const int ch = h * 64 + lane;
        const bf16_t* prow = A.P + (size_t)(row0 + 8 * w) * P_LD + ch;
#pragma unroll
        for (int u = 0; u < 8; ++u) { H.r[u] = prow[(size_t)u * P_LD + C_R]; H.k[u] = prow[(size_t)u * P_LD + C_K]; H.v[u] = prow[(size_t)u * P_LD + C_V]; }
        H.pr = 0; H.pk = 0; H.pv = 0;
        if (w > 0 || c > 0) { H.pr = prow[C_R - P_LD]; H.pk = prow[C_K - P_LD]; H.pv = prow[C_V - P_LD]; }
        H.w0c = A.w0[ch]; H.a0c = A.a0[ch]; H.kkc = A.k_k[ch]; H.kac = A.k_a[ch]; H.rkc = A.r_k[ch];
        H.mur = A.mu[ch]; H.muk = A.mu[512 + ch]; H.muv = A.mu[1024 + ch];
        const int m = w >> 2, cb = w & 1;
        const bf16_t* Wt = (m ? A.WiT : A.WdT) + (size_t)(h * 64 + 32 * cb + r32) * 64 + 8 * hh;
#pragma unroll
        for (int s = 0; s < 4; ++s) H.bf[s] = *(const bf16x8*)(Wt + 16 * s);
    };
    HeadIn Hn; load_head(Hn, 0);
    for (int h = 0; h < 8; ++h) {
        const int unit = (b * 8 + h) * 128 + c;
        unsigned char* ub = A.units + (size_t)unit * UNIT_BYTES;
        const HeadIn Hc = Hn;
        load_head(Hn, h < 7 ? h + 1 : 7);
        const bf16_t* g_r = Hc.r; const bf16_t* g_k = Hc.k; const bf16_t* g_v = Hc.v; const bf16_t g_pr = Hc.pr, g_pk = Hc.pk, g_pv = Hc.pv;
        const float w0c = Hc.w0c, a0c = Hc.a0c, kkc = Hc.kkc, kac = Hc.kac, rkc = Hc.rkc, mur = Hc.mur, muk = Hc.muk, muv = Hc.muv;
        float gamma_l = 1.f;
        {
            const int m = w >> 2, tb = (w >> 1) & 1, cb = w & 1;
            const RK_LAS unsigned char* Ab = lds + (m ? L_DA : L_TW);
            f32x16 acc = zero16(); (void)cb;
#pragma unroll
            for (int s = 0; s < 4; ++s) {
                const bf16x8 af = ldsfrag(Ab, 32 * tb + r32, 16 * s + 8 * hh);
                acc = __builtin_amdgcn_mfma_f32_32x32x16_bf16(af, Hc.bf[s], acc, 0, 0, 0);
            }
            RK_LAS float* F = m ? F2 : F1;
#pragma unroll
            for (int q = 0; q < 16; ++q) F[(32 * tb + drow(q, hh)) * PF + 32 * cb + r32] = acc[q];
        }
        RK_SYNC();
        {
            float lw[8], loc[8]; float run = 0.f;
#pragma unroll
            for (int u = 0; u < 8; ++u) {
                const float z = -(F1[(8 * w + u) * PF + lane] + w0c);
                const float sp = fmaxf(z, 0.f) + __logf(1.f + __expf(-fabsf(z)));
                lw[u] = -__expf(-sp - 0.5f); run += lw[u]; loc[u] = run;
            }
            RK_LAS float* GT = (RK_LAS float*)(lds + L_GT);
            GT[w * 64 + lane] = run;
            RK_SYNC();
            float off = 0.f, cumC = 0.f;
#pragma unroll
            for (int g = 0; g < 8; ++g) { const float v = GT[g * 64 + lane]; cumC += v; if (g < w) off += v; }
            gamma_l = __expf(cumC);
            if (w == 0) A.gam[(size_t)unit * 64 + lane] = gamma_l;
            float pr = b2f(g_pr), pk = b2f(g_pk), pv = b2f(g_pv);
            float eprev_c = __expf(off);
            float tb_[8], tk_[8], tv_[8];
            RK_LAS bf16_t* AP = (RK_LAS bf16_t*)(lds + L_AP); RK_LAS bf16_t* RP = (RK_LAS bf16_t*)(lds + L_RP); RK_LAS bf16_t* BM = (RK_LAS bf16_t*)(lds + L_BM); RK_LAS bf16_t* KM = (RK_LAS bf16_t*)(lds + L_KM);
            RK_LAS bf16_t* BHT = (RK_LAS bf16_t*)(lds + L_BHT); RK_LAS bf16_t* KHT = (RK_LAS bf16_t*)(lds + L_KHT); RK_LAS bf16_t* VT = (RK_LAS bf16_t*)(lds + L_VT);
#pragma unroll
            for (int u = 0; u < 8; ++u) {
                const int t = 8 * w + u;
                const float cr = b2f(g_r[u]), ck = b2f(g_k[u]), cv = b2f(g_v[u]);
                const float rr = cr + (pr - cr) * mur, kx = ck + (pk - ck) * muk, vx = cv + (pv - cv) * muv;
                pr = cr; pk = ck; pv = cv;
                const float iclr = __builtin_amdgcn_rcpf(1.f + __expf(-(F2[t * PF + lane] + a0c)));
                const float kkv = kx * kkc; const float kn = kkv * rsqrtf(fmaxf(wsum(kkv * kkv), 1e-24f));
                const float kt = kx * (1.f + (iclr - 1.f) * kac), av = -kn, bv = kn * iclr;
                const float bsum = wsum(rr * kt * rkc);
                if (lane == 0) A.bon[(size_t)(row0 + t) * 8 + h] = bsum;
                const float cum = off + loc[u];
                const float ecum = __expf(cum), einv = __builtin_amdgcn_rcpf(ecum), ehat = gamma_l * einv;
                const float eprev = eprev_c; eprev_c = ecum;
                AP[t * PB + lane] = f2b(av * eprev); RP[t * PB + lane] = f2b(rr * ecum); BM[t * PB + lane] = f2b(bv * einv); KM[t * PB + lane] = f2b(kt * einv);
                tb_[u] = bv * ehat; tk_[u] = kt * ehat; tv_[u] = vx;
            }
            *(RK_LAS v4u*)(BHT + lane * PB + 8 * w) = (v4u){cvtpk(tb_[0], tb_[1]), cvtpk(tb_[2], tb_[3]), cvtpk(tb_[4], tb_[5]), cvtpk(tb_[6], tb_[7])};
            *(RK_LAS v4u*)(KHT + lane * PB + 8 * w) = (v4u){cvtpk(tk_[0], tk_[1]), cvtpk(tk_[2], tk_[3]), cvtpk(tk_[4], tk_[5]), cvtpk(tk_[6], tk_[7])};
            *(RK_LAS v4u*)(VT + lane * PB + 8 * w) = (v4u){cvtpk(tv_[0], tv_[1]), cvtpk(tv_[2], tv_[3]), cvtpk(tv_[4], tv_[5]), cvtpk(tv_[6], tv_[7])};
        }
        RK_SYNC();
        {
            const int m = w >> 1, tb = w & 1;
            const RK_LAS unsigned char* Ab = lds + ((m < 2) ? L_AP : L_RP);
            const RK_LAS unsigned char* Bb = lds + ((m & 1) ? L_KM : L_BM);
            const bool incl = m >= 2;
#pragma unroll
            for (int jb = 0; jb < 2; ++jb) {
                f32x16 acc = zero16();
                if (jb <= tb) {
#pragma unroll
                    for (int s = 0; s < 4; ++s) acc = __builtin_amdgcn_mfma_f32_32x32x16_bf16(ldsfrag(Ab, 32 * tb + r32, 16 * s + 8 * hh), ldsfrag(Bb, 32 * jb + r32, 16 * s + 8 * hh), acc, 0, 0, 0);
                }
                const int j = 32 * jb + r32;
#pragma unroll
                for (int q = 0; q < 16; ++q) {
                    const int t = 32 * tb + drow(q, hh);
                    const float v = (j < t || (incl && j == t)) ? acc[q] : 0.f;
                    if (m == 0) F3[t * PF + j] = v;
                    else ((RK_LAS bf16_t*)(lds + (m == 1 ? L_LAK : (m == 2 ? L_LRB : L_LRK))))[t * PB + j] = f2b(v);
                }
            }
        }
        RK_SYNC();
        if (w < 4) {
            const int ib = w >> 1, tb = w & 1;
            f32x16 acc = zero16();
#pragma unroll
            for (int s = 0; s < 4; ++s) acc = __builtin_amdgcn_mfma_f32_32x32x16_bf16(ldsfrag(lds + L_VT, 32 * ib + r32, 16 * s + 8 * hh), ldsfrag(lds + L_LAK, 32 * tb + r32, 16 * s + 8 * hh), acc, 0, 0, 0);
#pragma unroll
            for (int q = 0; q < 16; ++q) F1[(32 * ib + drow(q, hh)) * PF + 32 * tb + r32] = acc[q];
        } else {
            const int qb = w - 4, l15 = lane & 15, g = lane >> 4;
            RK_LAS float* X = (RK_LAS float*)(lds + L_SCR) + (w - 4) * 2 * 272;
            RK_LAS float* Y = X + 272;
            RK_LAS float* TI = (RK_LAS float*)(lds + L_TI) + qb * 272;
#pragma unroll
            for (int e = 0; e < 4; ++e) { const int rr = 4 * g + e; const float v = F3[(16 * qb + rr) * PF + 16 * qb + l15]; X[rr * 17 + l15] = v; TI[rr * 17 + l15] = v + (rr == l15 ? 1.f : 0.f); }
            asm volatile("s_waitcnt lgkmcnt(0)" ::: "memory");
#pragma unroll
            for (int it = 0; it < 3; ++it) {
                f32x4 acc = {0.f, 0.f, 0.f, 0.f};
#pragma unroll
                for (int s = 0; s < 4; ++s) acc = __builtin_amdgcn_mfma_f32_16x16x4f32(X[l15 * 17 + 4 * s + g], X[(4 * s + g) * 17 + l15], acc, 0, 0, 0);
#pragma unroll
                for (int e = 0; e < 4; ++e) Y[(4 * g + e) * 17 + l15] = acc[e];
                asm volatile("s_waitcnt lgkmcnt(0)" ::: "memory");
                f32x4 acc2;
#pragma unroll
                for (int e = 0; e < 4; ++e) acc2[e] = TI[(4 * g + e) * 17 + l15];
#pragma unroll
                for (int s = 0; s < 4; ++s) acc2 = __builtin_amdgcn_mfma_f32_16x16x4f32(TI[l15 * 17 + 4 * s + g], Y[(4 * s + g) * 17 + l15], acc2, 0, 0, 0);
                asm volatile("s_waitcnt lgkmcnt(0)" ::: "memory");
#pragma unroll
                for (int e = 0; e < 4; ++e) TI[(4 * g + e) * 17 + l15] = acc2[e];
                RK_LAS float* tsw = X; X = Y; Y = tsw;
                asm volatile("s_waitcnt lgkmcnt(0)" ::: "memory");
            }
        }
        RK_SYNC();
        {
            const int l15 = lane & 15, g = lane >> 4;
            RK_LAS float* SC = (RK_LAS float*)(lds + L_SCR) + w * 272;
            const RK_LAS float* TIb = (const RK_LAS float*)(lds + L_TI);
            float xa[3][4];
#pragma unroll
            for (int i = 0; i < 4; ++i) {
                f32x4 acc;
                if (w < 4) { const v2u u2 = *(const RK_LAS v2u*)(lds + L_AP + ((16 * i + l15) * PB + 16 * w + 4 * g) * 2); acc = (f32x4){blo(u2.x), bhi(u2.x), blo(u2.y), bhi(u2.y)}; }
                else {
#pragma unroll
                    for (int e = 0; e < 4; ++e) acc[e] = F1[(16 * (w - 4) + 4 * g + e) * PF + 16 * i + l15];
                }
#pragma unroll
                for (int j = 0; j < 3; ++j) if (j < i) {
#pragma unroll
                    for (int s = 0; s < 4; ++s) acc = __builtin_amdgcn_mfma_f32_16x16x4f32(xa[j][s], F3[(16 * i + l15) * PF + 16 * j + 4 * s + g], acc, 0, 0, 0);
                }
#pragma unroll
                for (int e = 0; e < 4; ++e) SC[(4 * g + e) * 17 + l15] = acc[e];
                asm volatile("s_waitcnt lgkmcnt(0)" ::: "memory");
                f32x4 xi = {0.f, 0.f, 0.f, 0.f};
#pragma unroll
                for (int s = 0; s < 4; ++s) xi = __builtin_amdgcn_mfma_f32_16x16x4f32(SC[l15 * 17 + 4 * s + g], TIb[i * 272 + l15 * 17 + 4 * s + g], xi, 0, 0, 0);
                asm volatile("s_waitcnt lgkmcnt(0)" ::: "memory");
                RK_LAS bf16_t* O = (RK_LAS bf16_t*)(lds + (w < 4 ? L_WT : L_U0));
#pragma unroll
                for (int e = 0; e < 4; ++e) O[(16 * (w & 3) + 4 * g + e) * PB + 16 * i + l15] = f2b(xi[e]);
                if (i < 3) {
#pragma unroll
                    for (int e = 0; e < 4; ++e) SC[(4 * g + e) * 17 + l15] = xi[e];
                    asm volatile("s_waitcnt lgkmcnt(0)" ::: "memory");
#pragma unroll
                    for (int s = 0; s < 4; ++s) xa[i][s] = SC[l15 * 17 + 4 * s + g];
                    asm volatile("s_waitcnt lgkmcnt(0)" ::: "memory");
                }
            }
        }
        RK_SYNC();
        {
            const int m = w >> 1, x = w & 1;
#pragma unroll
            for (int y = 0; y < 2; ++y) {
                f32x16 acc = zero16();
                if (m == 2) {
#pragma unroll
                    for (int qq = 0; qq < 4; ++qq) { const v2u u2 = *(const RK_LAS v2u*)(lds + L_RP + ((32 * y + r32) * PB + 32 * x + 8 * qq + 4 * hh) * 2);
                        acc[4 * qq + 0] = blo(u2.x); acc[4 * qq + 1] = bhi(u2.x); acc[4 * qq + 2] = blo(u2.y); acc[4 * qq + 3] = bhi(u2.y); }
                }
                const int A1 = (m == 0 || m == 2) ? L_WT : (m == 1 ? L_BHT : L_U0);
                const int B1 = (m == 0) ? L_BHT : (m == 1 ? L_U0 : L_LRB);
#pragma unroll
                for (int s = 0; s < 4; ++s) acc = __builtin_amdgcn_mfma_f32_32x32x16_bf16(ldsfrag(lds + A1, 32 * x + r32, 16 * s + 8 * hh), ldsfrag(lds + B1, 32 * y + r32, 16 * s + 8 * hh), acc, 0, 0, 0);
                if (m == 1 || m == 3) {
                    const int A2 = (m == 1) ? L_KHT : L_VT, B2 = (m == 1) ? L_VT : L_LRK;
#pragma unroll
                    for (int s = 0; s < 4; ++s) acc = __builtin_amdgcn_mfma_f32_32x32x16_bf16(ldsfrag(lds + A2, 32 * x + r32, 16 * s + 8 * hh), ldsfrag(lds + B2, 32 * y + r32, 16 * s + 8 * hh), acc, 0, 0, 0);
                }
                if (m == 0 && x == y) {
                    const float go = __shfl_xor(gamma_l, 32); const float gn = (hh == y) ? gamma_l : go;
#pragma unroll
                    for (int q = 0; q < 16; ++q) if (drow(q, hh) == r32) acc[q] -= (1.f - gn);
                }
                store_dfrag(ub + m * 8192 + (x * 2 + y) * 2048, lane, acc);
            }
        }
        RK_SYNC();
    }
}

struct R2Args { const unsigned char* units; const float* gam; unsigned char* zs; };
constexpr int R2_SLOT = 16384, R2_NS = 8, R2_X = R2_NS * R2_SLOT;
__device__ __forceinline__ void r2_block(const R2Args& A, RK_LAS unsigned char* lds, int bh, const int wid_in) {
    const int lane = hw_lane_id(), w = wid_in;
    if (w >= 4) {
        const int lw = w - 4;
        v4u buf[8][4];
        const unsigned char* ubase = A.units + (size_t)bh * 128 * UNIT_BYTES + lw * 1024 + lane * 16;
        const int d0 = lw * 1024 + lane * 16;
#pragma unroll
        for (int c = 0; c < 7; ++c) {
            v4u a[4];
#pragma unroll
            for (int k = 0; k < 4; ++k) a[k] = *(const v4u*)(ubase + (size_t)c * UNIT_BYTES + k * 4096);
#pragma unroll
            for (int k = 0; k < 4; ++k) *(RK_LAS v4u*)(lds + c * R2_SLOT + d0 + k * 4096) = a[k];
        }
#pragma unroll
        for (int c = 7; c < 15; ++c)
#pragma unroll
            for (int k = 0; k < 4; ++k) buf[c & 7][k] = *(const v4u*)(ubase + (size_t)c * UNIT_BYTES + k * 4096);
        __syncthreads();
        __syncthreads();
        for (int c0 = 0; c0 < 128; c0 += 8) {
#pragma unroll
            for (int u = 0; u < 8; ++u) {
                const int c = c0 + u;
                RK_LAS unsigned char* slot = lds + ((u + 7) & 7) * R2_SLOT + d0;
#pragma unroll
                for (int k = 0; k < 4; ++k) *(RK_LAS v4u*)(slot + k * 4096) = buf[(u + 7) & 7][k];
                const int cn = (c + 15 < 128) ? c + 15 : 127;
#pragma unroll
                for (int k = 0; k < 4; ++k) buf[(u + 7) & 7][k] = *(const v4u*)(ubase + (size_t)cn * UNIT_BYTES + k * 4096);
                __syncthreads();
            }
        }
    } else {
        const int rt = w >> 1, cb = w & 1, pw = w ^ 2;
        f32x16 Z = zero16();
        bf16x8 zo[2];
        { const v4u z4 = {0u, 0u, 0u, 0u}; zo[0] = __builtin_bit_cast(bf16x8, z4); zo[1] = zo[0];
          *(RK_LAS bf16x8*)(lds + R2_X + (0 * 4 + w) * 2048 + lane * 32) = zo[0]; *(RK_LAS bf16x8*)(lds + R2_X + (0 * 4 + w) * 2048 + lane * 32 + 16) = zo[0]; }
        bf16x8 pa[2][2], pb[2][2]; v4u qa[2], qb[2];
        __syncthreads();
#define R2_READ(P_, Q_, SLOT_) do { _Pragma("unroll") for (int kb = 0; kb < 2; ++kb) { const RK_LAS bf16x8* pp = (const RK_LAS bf16x8*)((SLOT_) + (kb * 2 + rt) * 2048 + lane * 32); P_[kb][0] = pp[0]; P_[kb][1] = pp[1]; } \
        { const RK_LAS v4u* qp = (const RK_LAS v4u*)((SLOT_) + 8192 + (rt * 2 + cb) * 2048 + lane * 32); Q_[0] = qp[0]; Q_[1] = qp[1]; } } while (0)
#define R2_STEP(P_, Q_, C_) do { \
        const RK_LAS bf16x8* xp = (const RK_LAS bf16x8*)(lds + R2_X + (((C_) & 1) * 4 + pw) * 2048 + lane * 32); const bf16x8 zp0 = xp[0], zp1 = xp[1]; \
        { v4u* zg = (v4u*)(zb + (size_t)(C_) * 8192 + (rt * 2 + cb) * 2048 + lane * 32); zg[0] = __builtin_bit_cast(v4u, zo[0]); zg[1] = __builtin_bit_cast(v4u, zo[1]); } \
        const unsigned qu[8] = {Q_[0].x, Q_[0].y, Q_[0].z, Q_[0].w, Q_[1].x, Q_[1].y, Q_[1].z, Q_[1].w}; \
        f32x16 acc; _Pragma("unroll") for (int q = 0; q < 16; ++q) acc[q] = Z[q] + ((q & 1) ? bhi(qu[q >> 1]) : blo(qu[q >> 1])); \
        _Pragma("unroll") for (int kb = 0; kb < 2; ++kb) { \
            acc = __builtin_amdgcn_mfma_f32_32x32x16_bf16(P_[kb][0], (kb == rt) ? zo[0] : zp0, acc, 0, 0, 0); \
            acc = __builtin_amdgcn_mfma_f32_32x32x16_bf16(P_[kb][1], (kb == rt) ? zo[1] : zp1, acc, 0, 0, 0); } \
        Z = acc; zo[0] = pack8(Z, 0); zo[1] = pack8(Z, 1); \
        { RK_LAS bf16x8* xo = (RK_LAS bf16x8*)(lds + R2_X + ((((C_) + 1) & 1) * 4 + w) * 2048 + lane * 32); xo[0] = zo[0]; xo[1] = zo[1]; } } while (0)
        R2_READ(pa, qa, lds);
        asm volatile("s_waitcnt lgkmcnt(0)" ::: "memory");
        __syncthreads();
        unsigned char* zb = A.zs + (size_t)(bh * 128) * 8192;
        for (int c = 0; c < 128; c += 2) {
            R2_READ(pb, qb, lds + ((c + 1) & 7) * R2_SLOT);
            R2_STEP(pa, qa, c);
            __syncthreads();
            R2_READ(pa, qa, lds + ((c + 2) & 7) * R2_SLOT);
            R2_STEP(pb, qb, c + 1);
            __syncthreads();
        }
#undef R2_READ
#undef R2_STEP
    }
}

struct R3Args { const bf16_t* P; const float *mu, *lnw, *lnb; const bf16_t* WgT; const unsigned char* units; const unsigned char* zs; const float* bon; bf16_t* ymix; float* ypre; float* gdbg; };
constexpr int R3_SG = 0, R3_PITCH = 136, R3_V = 64 * 136 * 2, R3_VP = 520, R3_LN = R3_V + 64 * R3_VP * 2, R3_LDS = R3_LN + 4096;
__device__ __forceinline__ void r3_block(const R3Args& A, RK_LAS unsigned char* lds, int bc, const int wid_in) {
    const int lane = hw_lane_id(), h = wid_in, tid = h * 64 + lane, r32 = lane & 31, hh = lane >> 5;
    const int b = bc >> 7, c = bc & 127, row0 = b * 8192 + c * 64;
    const int unit = (b * 8 + h) * 128 + c;
    const unsigned char* ub = A.units + (size_t)unit * UNIT_BYTES;
    const unsigned char* zb = A.zs + (size_t)unit * 8192;
    bf16x8 zf[2][2][2], gf[2][2][2];
#pragma unroll
    for (int kb = 0; kb < 2; ++kb)
#pragma unroll
        for (int x = 0; x < 2; ++x) {
            const bf16x8* zp = (const bf16x8*)(zb + (kb * 2 + x) * 2048 + lane * 32); zf[kb][x][0] = __builtin_nontemporal_load(zp); zf[kb][x][1] = __builtin_nontemporal_load(zp + 1);
            const bf16x8* gp = (const bf16x8*)(ub + 2 * 8192 + (kb * 2 + x) * 2048 + lane * 32); gf[kb][x][0] = __builtin_nontemporal_load(gp); gf[kb][x][1] = __builtin_nontemporal_load(gp + 1);
        }
    const float bon2[2] = {A.bon[(size_t)(row0 + r32) * 8 + h], A.bon[(size_t)(row0 + 32 + r32) * 8 + h]};
    if (tid < 256) { const f32x4 v = *(const f32x4*)((tid < 128 ? A.lnw : A.lnb) + 4 * (tid & 127)); *(RK_LAS f32x4*)(lds + R3_LN + tid * 16) = v; }
    {
        const int t = tid >> 3, cg = tid & 7;
        const bf16_t* pc = A.P + (size_t)(row0 + t) * P_LD + C_DG + cg * 16;
        const bool hp = (t > 0 || c > 0); const int pofs = hp ? -P_LD : 0;
        const v4u zero4 = {0, 0, 0, 0};
        const bf16_t* pvr = A.P + (size_t)(row0 + t) * P_LD + C_V + cg * 64;
        v4u vc[8], vp[8];
#pragma unroll
        for (int k = 0; k < 8; ++k) { vc[k] = *(const v4u*)(pvr + 8 * k); vp[k] = *(const v4u*)(pvr + pofs + 8 * k); }
        v4u c0 = *(const v4u*)pc, c1 = *(const v4u*)(pc + 8), p0 = *(const v4u*)(pc + pofs), p1 = *(const v4u*)(pc + pofs + 8);
        p0 = hp ? p0 : zero4; p1 = hp ? p1 : zero4;
        const unsigned cu[8] = {c0.x, c0.y, c0.z, c0.w, c1.x, c1.y, c1.z, c1.w}, pu[8] = {p0.x, p0.y, p0.z, p0.w, p1.x, p1.y, p1.z, p1.w};
        const float* mup = A.mu + (C_DG - C_R) + cg * 16;
        unsigned o[8];
#pragma unroll
        for (int i = 0; i < 8; ++i) {
            float x0 = blo(cu[i]), x1 = bhi(cu[i]); const float q0 = blo(pu[i]), q1 = bhi(pu[i]);
            x0 = x0 + (q0 - x0) * mup[2 * i]; x1 = x1 + (q1 - x1) * mup[2 * i + 1];
            o[i] = cvtpk(__builtin_amdgcn_rcpf(1.f + __expf(-x0)), __builtin_amdgcn_rcpf(1.f + __expf(-x1)));
        }
        RK_LAS v4u* dst = (RK_LAS v4u*)(lds + R3_SG + (t * R3_PITCH + cg * 16) * 2);
        dst[0] = (v4u){o[0], o[1], o[2], o[3]}; dst[1] = (v4u){o[4], o[5], o[6], o[7]};
        const float* muv = A.mu + 1024 + cg * 64;
#pragma unroll
        for (int k = 0; k < 8; ++k) {
            const v4u cv = vc[k]; const v4u pv4 = hp ? vp[k] : zero4;
            const unsigned cw[4] = {cv.x, cv.y, cv.z, cv.w}, pw[4] = {pv4.x, pv4.y, pv4.z, pv4.w};
            unsigned ov[4];
#pragma unroll
            for (int i = 0; i < 4; ++i) { const float a0 = blo(cw[i]), a1 = bhi(cw[i]); ov[i] = cvtpk(a0 + (blo(pw[i]) - a0) * muv[8 * k + 2 * i], a1 + (bhi(pw[i]) - a1) * muv[8 * k + 2 * i + 1]); }
            *(RK_LAS v4u*)(lds + R3_V + (t * R3_VP + cg * 64 + 8 * k) * 2) = (v4u){ov[0], ov[1], ov[2], ov[3]};
        }
    }
    RK_SYNC();
#pragma unroll
    for (int tb = 0; tb < 2; ++tb) {
        asm volatile("" ::: "memory");
        f32x16 y[2];
#pragma unroll
        for (int ib = 0; ib < 2; ++ib) {
            const v4u* yp = (const v4u*)(ub + 3 * 8192 + (ib * 2 + tb) * 2048 + lane * 32);
            const v4u q0 = __builtin_nontemporal_load(yp), q1 = __builtin_nontemporal_load(yp + 1);
            const unsigned qu[8] = {q0.x, q0.y, q0.z, q0.w, q1.x, q1.y, q1.z, q1.w};
            f32x16 acc;
#pragma unroll
            for (int q = 0; q < 16; ++q) acc[q] = (q & 1) ? bhi(qu[q >> 1]) : blo(qu[q >> 1]);
#pragma unroll
            for (int kb = 0; kb < 2; ++kb)
#pragma unroll
                for (int s = 0; s < 2; ++s) acc = __builtin_amdgcn_mfma_f32_32x32x16_bf16(zf[kb][ib][s], gf[kb][tb][s], acc, 0, 0, 0);
            y[ib] = acc;
        }
        f32x16 gt[2];
#pragma unroll
        for (int ib = 0; ib < 2; ++ib) {
            f32x16 acc = zero16();
            const bf16_t* wg = A.WgT + (size_t)(h * 64 + 32 * ib + r32) * 128 + 8 * hh;
#pragma unroll
            for (int s = 0; s < 8; ++s) acc = __builtin_amdgcn_mfma_f32_32x32x16_bf16(*(const bf16x8*)(wg + 16 * s), *(const RK_LAS bf16x8*)(lds + R3_SG + ((32 * tb + r32) * R3_PITCH + 16 * s + 8 * hh) * 2), acc, 0, 0, 0);
            gt[ib] = acc;
        }
        if (A.ypre) {
#pragma unroll
            for (int ib = 0; ib < 2; ++ib)
#pragma unroll
                for (int q = 0; q < 16; ++q) { const size_t o = (size_t)(row0 + 32 * tb + r32) * 512 + h * 64 + 32 * ib + drow(q, hh); A.ypre[o] = y[ib][q]; A.gdbg[o] = gt[ib][q]; }
        }
        float s1 = 0.f;
#pragma unroll
        for (int ib = 0; ib < 2; ++ib)
#pragma unroll
            for (int q = 0; q < 16; ++q) s1 += y[ib][q];
        s1 += __shfl_xor(s1, 32);
        const float mean = s1 * (1.f / 64.f);
        float s2 = 0.f;
#pragma unroll
        for (int ib = 0; ib < 2; ++ib)
#pragma unroll
            for (int q = 0; q < 16; ++q) { const float d = y[ib][q] - mean; s2 += d * d; }
        s2 += __shfl_xor(s2, 32);
        const float rstd = rsqrtf(s2 * (1.f / 64.f) + 64e-5f);
        const int t = 32 * tb + r32, row = row0 + t;
        const float bon = bon2[tb]; (void)row;
        RK_LAS unsigned char* vrow = lds + R3_V + (t * R3_VP + h * 64) * 2;
#pragma unroll
        for (int ib = 0; ib < 2; ++ib)
#pragma unroll
            for (int qq = 0; qq < 4; ++qq) {
                asm volatile("" ::: "memory");
                const int i0 = 32 * ib + 8 * qq + 4 * hh;
                const v2u cu = *(const RK_LAS v2u*)(vrow + i0 * 2);
                const float vxx[4] = {blo(cu.x), bhi(cu.x), blo(cu.y), bhi(cu.y)};
                const f32x4 lw4 = *(const RK_LAS f32x4*)(lds + R3_LN + (h * 64 + i0) * 4), lb4 = *(const RK_LAS f32x4*)(lds + R3_LN + 2048 + (h * 64 + i0) * 4);
                float o[4];
#pragma unroll
                for (int e = 0; e < 4; ++e) {
                    const float yn = (y[ib][4 * qq + e] - mean) * rstd * lw4[e] + lb4[e] + bon * vxx[e];
                    o[e] = yn * gt[ib][4 * qq + e];
                }
                *(RK_LAS v2u*)(vrow + i0 * 2) = (v2u){cvtpk(o[0], o[1]), cvtpk(o[2], o[3])};
            }
    }
    asm volatile("s_waitcnt lgkmcnt(0)" ::: "memory");
#pragma unroll
    for (int it = 0; it < 8; ++it) {
        const int t = it * 8 + (lane >> 3), ck = lane & 7;
        const v4u w4 = *(const RK_LAS v4u*)(lds + R3_V + (t * R3_VP + h * 64 + ck * 8) * 2);
        *(v4u*)(A.ymix + (size_t)(row0 + t) * 1024 + 512 + h * 64 + ck * 8) = w4;
    }
}
}
#ifndef REP_P0
#define REP_P0 1
#endif
#ifndef REP_G1
#define REP_G1 1
#endif
#ifndef REP_P3
#define REP_P3 1
#endif
#ifndef REP_P10
#define REP_P10 1
#endif
#ifndef REP_P6
#define REP_P6 1
#endif
#ifndef REP_R2
#define REP_R2 1
#endif
#ifndef P3_ITEMS
#define P3_ITEMS (240 * 8 * 16)
#endif
#ifndef TAIL_ITEMS
#define TAIL_ITEMS (192 * 8 * 6)
#endif
#ifndef REP_MOE
#define REP_MOE 1
#endif
namespace {
using pg8::bf16_t;
#define LAS __attribute__((address_space(3)))
#define GAS __attribute__((address_space(1)))
typedef unsigned v4u __attribute__((ext_vector_type(4)));
typedef float f32x4 __attribute__((ext_vector_type(4)));
constexpr int B_ = 2, S_ = 8192, D_ = 1024, T_ = B_ * S_;
constexpr int CW = 512, RW = 512, H_ = 8, N_ = 64;
constexpr int RC = 3 * RW + 64 + 64 + 128;
constexpr int INC = 3 * CW + RC;
constexpr int E_ = 32, TOPK = 4, FF = 1024;
constexpr int NP = T_ * TOPK;
constexpr int ROWS_PAD = NP + E_ * 256;
constexpr int NWAVES = 8, NTHR = 512, GRID = 256;
constexpr int MISC_OFF = 160512;
constexpr int LDS_BYTES = MISC_OFF + 256;
constexpr size_t MiB = 1u << 20;
constexpr size_t WS_CTL = 0;
constexpr size_t WS_WIN = 1 * MiB;
constexpr size_t WS_WOUT = 8 * MiB;
constexpr size_t WS_SMALL = 10 * MiB;
constexpr size_t WS_W2 = 14 * MiB;
constexpr size_t WS_LORA = 15 * MiB;
constexpr size_t WS_WGU = 16 * MiB;
constexpr size_t WS_WDN = 144 * MiB;
constexpr size_t WS_XN = 208 * MiB;
constexpr size_t WS_H1 = 240 * MiB;
constexpr size_t WS_YMIX = 304 * MiB;
constexpr size_t WS_P = 368 * MiB;
constexpr size_t WS_UNITS = 472 * MiB;
constexpr size_t WS_ZS = 536 * MiB;
constexpr size_t WS_GAM = 552 * MiB;
constexpr size_t WS_BON = 553 * MiB;
constexpr size_t WS_XS = 368 * MiB;
constexpr size_t WS_ACT = 512 * MiB;
constexpr size_t WS_YB = 656 * MiB;
constexpr int CW_BAR = 4096;
constexpr int CW_CNT = 8192, CW_CURSOR = 8192 + 64;
constexpr int SM_TOPI = 0, SM_TOPG = 65536, SM_ROWGATE = 131072, SM_PAIRROW = 131072 + 73728, SM_HIST = 131072 + 73728 + 65536, SM_ROWTOK = 131072 + 73728 + 65536 + 8192;

__device__ __forceinline__ float sigmoidf_(float x) { return 1.f / (1.f + __expf(-x)); }
__device__ __forceinline__ unsigned f2bf(float f) { unsigned u = __builtin_bit_cast(unsigned, f); return (u + 0x7fffu + ((u >> 16) & 1u)) >> 16; }
__device__ __forceinline__ unsigned pk2(float lo, float hi) { return f2bf(lo) | (f2bf(hi) << 16); }
__device__ __forceinline__ float bf2f(unsigned short b) { return __builtin_bit_cast(float, (unsigned)b << 16); }
#define XB_TMO      128
#define XB_XCNT(j)  (256  + 64 * (j))
#define XB_XSUB(j)  (1280 + 64 * (j))
#define XB_XGEN(j)  (2304 + 64 * (j))
#define XB_TOP      3328
#define XB_TOPGEN   3392
#define XCD_BAR_WORDS 3456
#define XB_SPIN_CAP (1u << 18)

__device__ __forceinline__ unsigned xb_ld(unsigned* p)              { return __hip_atomic_load(p, __ATOMIC_RELAXED, __HIP_MEMORY_SCOPE_AGENT); }
__device__ __forceinline__ unsigned xb_add(unsigned* p, unsigned v) { return __hip_atomic_fetch_add(p, v, __ATOMIC_RELAXED, __HIP_MEMORY_SCOPE_AGENT); }
__device__ __forceinline__ unsigned xb_xcc_id() { return (unsigned)__builtin_amdgcn_s_getreg((3 << 11) | 20) & 0xFu; }
#define XB_SPIN(cond, bar) do { unsigned _sp = 0; while (cond) { __builtin_amdgcn_s_sleep(1); \
    if ((++_sp & 255u) == 0u) { if (xb_ld(&(bar)[XB_TMO])) break; if (_sp > XB_SPIN_CAP) { atomicAdd(&(bar)[XB_TMO], 1u); break; } } } } while (0)

struct XcdBarrier {
    unsigned* bar; unsigned x; int w0;
    volatile LAS unsigned* st;
};

__device__ __forceinline__ XcdBarrier xcd_barrier_post(unsigned* bar, volatile LAS unsigned* st) {
    XcdBarrier b; b.bar = bar; b.x = xb_xcc_id(); b.st = st;
    if (threadIdx.x == 0) (void)xb_add(&bar[XB_XCNT(b.x)], 1u);
    return b;
}
__device__ __forceinline__ void xcd_barrier_complete(unsigned* bar, unsigned x, unsigned& nloc, unsigned& nx) {
    const unsigned G = gridDim.x * gridDim.y * gridDim.z;
    unsigned sum, cnt, mine, sp = 0u;
    for (;;) {
        sum = 0u; cnt = 0u; mine = 0u;
#pragma unroll
        for (unsigned j = 0; j < 16; ++j) { const unsigned c = xb_ld(&bar[XB_XCNT(j)]); sum += c; cnt += (c > 0u) ? 1u : 0u; mine = (j == x) ? c : mine; }
        if (sum == G) break;
        __builtin_amdgcn_s_sleep(1);
        if ((++sp & 255u) == 0u) { if (xb_ld(&bar[XB_TMO])) break; if (sp > XB_SPIN_CAP) { atomicAdd(&bar[XB_TMO], 1u); break; } }
    }
    nloc = mine > 0u ? mine : 1u; nx = cnt > 0u ? cnt : 1u;
}

__device__ __forceinline__ void xcd_barrier(const XcdBarrier& b) {
    asm volatile("s_waitcnt vmcnt(0)" ::: "memory");
    __syncthreads();
    if (b.w0 == 0 && hw_lane_id() == 0) {
        unsigned* bar = b.bar;
        __builtin_amdgcn_s_waitcnt(0);
        unsigned nloc = b.st[0], nx = b.st[1];
        if (nloc == 0u) { xcd_barrier_complete(bar, b.x, nloc, nx); b.st[0] = nloc; b.st[1] = nx; }
        const unsigned old = xb_add(&bar[XB_XSUB(b.x)], 1u);
        const unsigned gen = old / nloc;
        if (old + 1u == (gen + 1u) * nloc) {
            __builtin_amdgcn_fence(__ATOMIC_RELEASE, "agent");
            asm volatile("s_waitcnt vmcnt(0)" ::: "memory");
            const unsigned og = xb_add(&bar[XB_TOP], 1u);
            const unsigned tg = og / nx;
            if (og + 1u == (tg + 1u) * nx) xb_add(&bar[XB_TOPGEN], 1u);
            else XB_SPIN(xb_ld(&bar[XB_TOPGEN]) == tg, bar);
            __builtin_amdgcn_fence(__ATOMIC_ACQUIRE, "agent");
            xb_add(&bar[XB_XGEN(b.x)], 1u);
            asm volatile("s_waitcnt vmcnt(0)" ::: "memory");
        } else {
            XB_SPIN(xb_ld(&bar[XB_XGEN(b.x)]) == gen, bar);
            __builtin_amdgcn_fence(__ATOMIC_ACQUIRE, "agent");
            asm volatile("s_waitcnt vmcnt(0)" ::: "memory");
        }
    }
    __syncthreads();
}

struct MapPlain { int off; __device__ __forceinline__ int operator()(int n) const { return off + n; } };
struct MapGU { int e; __device__ __forceinline__ int operator()(int oc) const { const int a = oc >> 1, gl = oc & 1; return e * 2048 + (a >> 7) * 256 + gl * 128 + (a & 127); } };
struct MapDN { int e; __device__ __forceinline__ int operator()(int n) const { return e * 1024 + (n & ~255) + ((n >> 3) & 1) * 128 + ((n >> 6) & 3) * 32 + ((n >> 4) & 3) * 8 + (n & 7); } };
template <class Map>
__device__ __forceinline__ void transpose_item(const float* W, int K, int N, bf16_t* WT, const Map& map, LAS float* scr, int item, int lane) {
    const int nblk = N / 32, kb = item / nblk, nb = item % nblk, k0 = 64 * kb, n0 = 32 * nb;
#pragma unroll 8
    for (int i = 0; i < 32; ++i) { const int kk = 2 * i + (lane >> 5); scr[kk * 33 + (lane & 31)] = W[(size_t)(k0 + kk) * N + n0 + (lane & 31)]; }
    asm volatile("s_waitcnt lgkmcnt(0)" ::: "memory");
    const int c = lane & 7;
#pragma unroll
    for (int j = 0; j < 4; ++j) { const int n = (lane >> 3) + 8 * j; const LAS float* s = scr + (8 * c) * 33 + n;
        v4u o; o.x = pk2(s[0 * 33], s[1 * 33]); o.y = pk2(s[2 * 33], s[3 * 33]); o.z = pk2(s[4 * 33], s[5 * 33]); o.w = pk2(s[6 * 33], s[7 * 33]);
        *(v4u*)(WT + (size_t)map(n0 + n) * K + k0 + 8 * c) = o; }
    asm volatile("s_waitcnt lgkmcnt(0)" ::: "memory");
}

template <class Map>
__device__ __forceinline__ void transpose_item8(const float* W, int K, int N, unsigned char* WT, const Map& map, LAS float* scr, int item, int lane) {
    const int nblk = N / 32, kb = item / nblk, nb = item % nblk, k0 = 64 * kb, n0 = 32 * nb;
#pragma unroll 8
    for (int i = 0; i < 32; ++i) { const int kk = 2 * i + (lane >> 5); scr[kk * 33 + (lane & 31)] = __builtin_nontemporal_load(W + (size_t)(k0 + kk) * N + n0 + (lane & 31)); }
    asm volatile("s_waitcnt lgkmcnt(0)" ::: "memory");
    const int c = lane & 7;
    typedef unsigned u32x2 __attribute__((ext_vector_type(2)));
#pragma unroll
    for (int j = 0; j < 4; ++j) { const int n = (lane >> 3) + 8 * j; const LAS float* s = scr + (8 * c) * 33 + n;
        u32x2 o; o.x = pg8::pk4_fp8(s[0 * 33] * 32.f, s[1 * 33] * 32.f, s[2 * 33] * 32.f, s[3 * 33] * 32.f); o.y = pg8::pk4_fp8(s[4 * 33] * 32.f, s[5 * 33] * 32.f, s[6 * 33] * 32.f, s[7 * 33] * 32.f);
        __builtin_nontemporal_store(o, (u32x2*)(WT + (size_t)map(n0 + n) * K + k0 + 8 * c)); }
    asm volatile("s_waitcnt lgkmcnt(0)" ::: "memory");
}
__device__ __forceinline__ void rms_row_to_bf16(const float* xrow, const float* w, bf16_t* orow, int lane) {
    const f32x4* xr = (const f32x4*)xrow + lane; const f32x4* wr = (const f32x4*)w + lane;
    f32x4 v[4]; float s = 0.f;
#pragma unroll
    for (int j = 0; j < 4; ++j) { v[j] = xr[64 * j]; s += (v[j].x * v[j].x + v[j].y * v[j].y) + (v[j].z * v[j].z + v[j].w * v[j].w); }
    s = rk::wsum(s);
    const float r = rsqrtf(s * (1.f / D_) + 1e-5f);
    unsigned long long* o8 = (unsigned long long*)orow + lane;
#pragma unroll
    for (int j = 0; j < 4; ++j) { const f32x4 ww = wr[64 * j]; o8[64 * j] = (unsigned long long)pk2(v[j].x * r * ww.x, v[j].y * r * ww.y) | ((unsigned long long)pk2(v[j].z * r * ww.z, v[j].w * r * ww.w) << 32); }
}

struct Args {
    const float *x, *nmw, *w_in, *conv_w, *mu, *w0, *wdu, *a0, *wiu, *wgu, *k_k, *k_a, *r_k, *lnw, *lnb, *w_out, *nfw, *rw, *rb, *gu_w, *gu_b, *dn_w, *dn_b, *nfinal;
    float* out; unsigned char* ws;
};

__device__ __forceinline__ void conv_rows(const bf16_t* __restrict__ P, const float* __restrict__ cw, bf16_t* __restrict__ ymix, int gw, int ngw, int lane) {
    const int c0 = lane * 8;
    float w0[8], w1[8], w2[8];
#pragma unroll
    for (int i = 0; i < 8; ++i) { w0[i] = cw[c0 + i]; w1[i] = cw[CW + c0 + i]; w2[i] = cw[2 * CW + c0 + i]; }
    for (int row = gw; row < T_; row += ngw) {
        const int t = row % S_;
        const bf16_t* pr = P + (size_t)row * INC + c0;
        const v4u cb = *(const v4u*)pr, cc0 = *(const v4u*)(pr + CW), ch0 = *(const v4u*)(pr + 2 * CW);
        v4u cc1 = {0, 0, 0, 0}, ch1 = {0, 0, 0, 0}, cc2 = {0, 0, 0, 0}, ch2 = {0, 0, 0, 0};
        if (t >= 1) { cc1 = *(const v4u*)(pr - INC + CW); ch1 = *(const v4u*)(pr - INC + 2 * CW); }
        if (t >= 2) { cc2 = *(const v4u*)(pr - 2 * INC + CW); ch2 = *(const v4u*)(pr - 2 * INC + 2 * CW); }
        const unsigned b_[4] = {cb.x, cb.y, cb.z, cb.w}, a0[4] = {cc0.x, cc0.y, cc0.z, cc0.w}, h0[4] = {ch0.x, ch0.y, ch0.z, ch0.w};
        const unsigned a1[4] = {cc1.x, cc1.y, cc1.z, cc1.w}, h1[4] = {ch1.x, ch1.y, ch1.z, ch1.w}, a2[4] = {cc2.x, cc2.y, cc2.z, cc2.w}, h2[4] = {ch2.x, ch2.y, ch2.z, ch2.w};
        unsigned o[4];
#pragma unroll
        for (int i = 0; i < 4; ++i) {
            const float u0l = rk::blo(a0[i]) * rk::blo(h0[i]), u0h = rk::bhi(a0[i]) * rk::bhi(h0[i]);
            const float u1l = rk::blo(a1[i]) * rk::blo(h1[i]), u1h = rk::bhi(a1[i]) * rk::bhi(h1[i]);
            const float u2l = rk::blo(a2[i]) * rk::blo(h2[i]), u2h = rk::bhi(a2[i]) * rk::bhi(h2[i]);
            const float yl = w0[2 * i] * u2l + w1[2 * i] * u1l + w2[2 * i] * u0l, yh = w0[2 * i + 1] * u2h + w1[2 * i + 1] * u1h + w2[2 * i + 1] * u0h;
            o[i] = pk2(rk::blo(b_[i]) * yl, rk::bhi(b_[i]) * yh);
        }
        __builtin_nontemporal_store((v4u){o[0], o[1], o[2], o[3]}, (v4u*)(ymix + (size_t)row * D_ + c0));
    }
}
__device__ __forceinline__ void router_rows2(const bf16_t* h1, const float* nfw, const float* rb, int row0, int lane, bf16_t* xn2, int* sm, LAS unsigned* cnt, const LAS float* wl, bool docount) {
    f32x4 v[2][4];
#pragma unroll
    for (int r = 0; r < 2; ++r) {
        const unsigned long long* xr = (const unsigned long long*)(h1 + (size_t)(row0 + r) * D_);
        float s = 0.f;
#pragma unroll
        for (int j = 0; j < 4; ++j) { const unsigned long long tq = xr[lane + 64 * j];
            v[r][j] = (f32x4){bf2f((unsigned short)tq), bf2f((unsigned short)(tq >> 16)), bf2f((unsigned short)(tq >> 32)), bf2f((unsigned short)(tq >> 48))};
            s += v[r][j].x * v[r][j].x + v[r][j].y * v[r][j].y + v[r][j].z * v[r][j].z + v[r][j].w * v[r][j].w; }
        s = rk::wsum(s);
        const float rs = rsqrtf(s * (1.f / D_) + 1e-5f);
        unsigned* o4 = (unsigned*)((unsigned char*)xn2 + (size_t)(row0 + r) * D_);
        const f32x4* wr = (const f32x4*)nfw;
#pragma unroll
        for (int j = 0; j < 4; ++j) { const f32x4 ww = wr[lane + 64 * j]; v[r][j].x *= rs * ww.x; v[r][j].y *= rs * ww.y; v[r][j].z *= rs * ww.z; v[r][j].w *= rs * ww.w;
            o4[lane + 64 * j] = pg8::pk4_fp8(v[r][j].x, v[r][j].y, v[r][j].z, v[r][j].w); }
    }
    float pa[2][32];
#pragma unroll
    for (int r = 0; r < 2; ++r)
#pragma unroll
        for (int e = 0; e < 32; ++e) pa[r][e] = 0.f;
#pragma unroll 1
    for (int j = 0; j < 4; ++j) {
        const float xv[2][4] = {{v[0][j].x, v[0][j].y, v[0][j].z, v[0][j].w}, {v[1][j].x, v[1][j].y, v[1][j].z, v[1][j].w}};
#pragma unroll
        for (int q = 0; q < 4; ++q) {
            const LAS f32x4* wrow = (const LAS f32x4*)(wl + (q * 256 + lane + 64 * j) * 36);
#pragma unroll
            for (int eh = 0; eh < 2; ++eh) {
#pragma unroll
                for (int e4 = 4 * eh; e4 < 4 * eh + 4; ++e4) { const f32x4 w4 = wrow[e4];
#pragma unroll
                    for (int r = 0; r < 2; ++r) { pa[r][4 * e4 + 0] += xv[r][q] * w4.x; pa[r][4 * e4 + 1] += xv[r][q] * w4.y; pa[r][4 * e4 + 2] += xv[r][q] * w4.z; pa[r][4 * e4 + 3] += xv[r][q] * w4.w; } }
                asm volatile("" ::: "memory");
            }
        }
    }
#pragma unroll
    for (int r = 0; r < 2; ++r) {
        float t16[16], t8[8], t4[4], t2[2], t1;
        { const bool h = (lane & 32) != 0;
#pragma unroll
          for (int i = 0; i < 16; ++i) { const float mine = h ? pa[r][16 + i] : pa[r][i], send = h ? pa[r][i] : pa[r][16 + i]; t16[i] = mine + __shfl_xor(send, 32); } }
        { const bool h = (lane & 16) != 0;
#pragma unroll
          for (int i = 0; i < 8; ++i) { const float mine = h ? t16[8 + i] : t16[i], send = h ? t16[i] : t16[8 + i]; t8[i] = mine + __shfl_xor(send, 16); } }
        { const bool h = (lane & 8) != 0;
#pragma unroll
          for (int i = 0; i < 4; ++i) { const float mine = h ? t8[4 + i] : t8[i], send = h ? t8[i] : t8[4 + i]; t4[i] = mine + __shfl_xor(send, 8); } }
        { const bool h = (lane & 4) != 0;
#pragma unroll
          for (int i = 0; i < 2; ++i) { const float mine = h ? t4[2 + i] : t4[i], send = h ? t4[i] : t4[2 + i]; t2[i] = mine + __shfl_xor(send, 4); } }
        { const bool h = (lane & 2) != 0; const float mine = h ? t2[1] : t2[0], send = h ? t2[0] : t2[1]; t1 = mine + __shfl_xor(send, 2); }
        t1 += __shfl_xor(t1, 1);
        const int me = lane >> 1;
        float mylogit = (lane & 1) ? -INFINITY : t1 + rb[me];
        float best[4]; int bi[4];
#pragma unroll
        for (int k = 0; k < 4; ++k) {
            float bv = mylogit; int bidx = (lane & 1) ? 1000 : me;
#pragma unroll
            for (int o = 1; o < 64; o <<= 1) { const float ov = __shfl_xor(bv, o); const int oi = __shfl_xor(bidx, o); if (ov > bv || (ov == bv && oi < bidx)) { bv = ov; bidx = oi; } }
            best[k] = bv; bi[k] = bidx;
            if (!(lane & 1) && me == bidx) mylogit = -INFINITY;
        }
        const float mx = best[0];
        float ex[4], den = 0.f;
#pragma unroll
        for (int k = 0; k < 4; ++k) { ex[k] = __expf(best[k] - mx); den += ex[k]; }
        if (lane < 4) {
            const float gsel = lane == 0 ? ex[0] : lane == 1 ? ex[1] : lane == 2 ? ex[2] : ex[3];
            const int isel = lane == 0 ? bi[0] : lane == 1 ? bi[1] : lane == 2 ? bi[2] : bi[3];
            sm[SM_TOPI + (row0 + r) * 4 + lane] = isel; ((float*)sm)[SM_TOPG + (row0 + r) * 4 + lane] = gsel / den;
            if (docount) __hip_atomic_fetch_add(&cnt[isel], 1u, __ATOMIC_RELAXED, __HIP_MEMORY_SCOPE_WORKGROUP);
        }
    }
}
__device__ __forceinline__ void final_row(const bf16_t* h1, const unsigned char* yb, const float* nfinal, float* out, int row, int lane, const int* sm) {
    const unsigned long long* xr = (const unsigned long long*)(h1 + (size_t)row * D_);
    f32x4 v[4], a[4];
#pragma unroll
    for (int j = 0; j < 4; ++j) { const unsigned long long tq = xr[lane + 64 * j]; v[j] = (f32x4){bf2f((unsigned short)tq), bf2f((unsigned short)(tq >> 16)), bf2f((unsigned short)(tq >> 32)), bf2f((unsigned short)(tq >> 48))}; a[j] = (f32x4){0.f, 0.f, 0.f, 0.f}; }
#pragma unroll
    for (int k = 0; k < 4; ++k) {
        const unsigned* yr = (const unsigned*)(yb + (size_t)sm[SM_PAIRROW + row * 4 + k] * D_);
#pragma unroll
        for (int j = 0; j < 4; ++j) { const unsigned t = __builtin_nontemporal_load(yr + lane + 64 * j);
            const auto lo = __builtin_amdgcn_cvt_pk_f32_fp8((int)t, false), hi = __builtin_amdgcn_cvt_pk_f32_fp8((int)t, true);
            a[j].x += lo[0]; a[j].y += lo[1]; a[j].z += hi[0]; a[j].w += hi[1]; }
    }
    float s = 0.f;
#pragma unroll
    for (int j = 0; j < 4; ++j) { v[j] = v[j] + a[j] * 0.03125f; s += v[j].x * v[j].x + v[j].y * v[j].y + v[j].z * v[j].z + v[j].w * v[j].w; }
    s = rk::wsum(s);
    const float r = rsqrtf(s * (1.f / D_) + 1e-5f);
    f32x4* yo = (f32x4*)(out + (size_t)row * D_);
    const f32x4* wr = (const f32x4*)nfinal;
#pragma unroll
    for (int j = 0; j < 4; ++j) { f32x4 ww = wr[lane + 64 * j]; __builtin_nontemporal_store((f32x4){v[j].x * r * ww.x, v[j].y * r * ww.y, v[j].z * r * ww.z, v[j].w * r * ww.w}, yo + lane + 64 * j); }
}


constexpr int RT_PL = 0, RT_PS = 65536, RT_LG = 65536 + 2048, RT_RS = RT_LG + 8192, RT_SEL = RT_RS + 256, RT_HIST = RT_SEL + 2048;
__device__ __forceinline__ void router_block(const bf16_t* h1, const bf16_t* w2, const float* nfw, const float* rb, bf16_t* xn2, int* sm, LAS unsigned char* lds, int bid, int wave, int lane) {
    typedef short bf16x8 __attribute__((ext_vector_type(8))); typedef float f32x16 __attribute__((ext_vector_type(16)));
    const int r32 = lane & 31, hh = lane >> 5, row0 = bid * 64, k0 = wave * 128;
    LAS float* PL = (LAS float*)(lds + RT_PL); LAS float* PS = (LAS float*)(lds + RT_PS); LAS float* LG = (LAS float*)(lds + RT_LG); LAS float* RS = (LAS float*)(lds + RT_RS);
    LAS float* SEL = (LAS float*)(lds + RT_SEL); LAS unsigned* hist = (LAS unsigned*)(lds + RT_HIST);
    if (wave == 0 && lane < 32) hist[lane] = 0u;
    bf16x8 a[2][8];
#pragma unroll
    for (int rt = 0; rt < 2; ++rt)
#pragma unroll
        for (int s = 0; s < 8; ++s) a[rt][s] = *(const bf16x8*)(h1 + (size_t)(row0 + 32 * rt + r32) * D_ + k0 + 16 * s + 8 * hh);
    f32x16 acc[2];
#pragma unroll
    for (int rt = 0; rt < 2; ++rt)
#pragma unroll
        for (int q = 0; q < 16; ++q) acc[rt][q] = 0.f;
#pragma unroll
    for (int s = 0; s < 8; ++s) {
        const bf16x8 bh = *(const bf16x8*)(w2 + (size_t)r32 * D_ + k0 + 16 * s + 8 * hh), bl = *(const bf16x8*)(w2 + (size_t)(32 + r32) * D_ + k0 + 16 * s + 8 * hh);
#pragma unroll
        for (int rt = 0; rt < 2; ++rt) { acc[rt] = __builtin_amdgcn_mfma_f32_32x32x16_bf16(a[rt][s], bh, acc[rt], 0, 0, 0); acc[rt] = __builtin_amdgcn_mfma_f32_32x32x16_bf16(a[rt][s], bl, acc[rt], 0, 0, 0); }
    }
#pragma unroll
    for (int rt = 0; rt < 2; ++rt) {
        float s2 = 0.f;
#pragma unroll
        for (int s = 0; s < 8; ++s) { const v4u u = __builtin_bit_cast(v4u, a[rt][s]);
            const float x0 = rk::blo(u.x), x1 = rk::bhi(u.x), x2 = rk::blo(u.y), x3 = rk::bhi(u.y), x4 = rk::blo(u.z), x5 = rk::bhi(u.z), x6 = rk::blo(u.w), x7 = rk::bhi(u.w);
            s2 += (x0 * x0 + x1 * x1) + (x2 * x2 + x3 * x3) + (x4 * x4 + x5 * x5) + (x6 * x6 + x7 * x7); }
        s2 += __shfl_xor(s2, 32);
        if (hh == 0) PS[wave * 64 + 32 * rt + r32] = s2;
#pragma unroll
        for (int q = 0; q < 16; ++q) PL[(wave * 64 + 32 * rt + rk::drow(q, hh)) * 32 + r32] = acc[rt][q];
    }
    __syncthreads();
    { const int tid = wave * 64 + lane;
      if (tid < 64) { float s = 0.f;
#pragma unroll
          for (int w2i = 0; w2i < 8; ++w2i) s += PS[w2i * 64 + tid];
          RS[tid] = rsqrtf(s * (1.f / D_) + 1e-5f); }
#pragma unroll
      for (int i = 0; i < 4; ++i) { const int idx = tid + 512 * i; float s = 0.f;
#pragma unroll
          for (int w2i = 0; w2i < 8; ++w2i) s += PL[w2i * 2048 + idx];
          LG[idx] = s; } }
    __syncthreads();
    {
        const int rl = 8 * wave + (lane >> 3), eg = lane & 7; const float rs = RS[rl];
        float mine[4];
#pragma unroll
        for (int i = 0; i < 4; ++i) mine[i] = LG[rl * 32 + 4 * eg + i] * rs + rb[4 * eg + i];
        int rank[4] = {0, 0, 0, 0};
#pragma unroll
        for (int e4 = 0; e4 < 8; ++e4) { const f32x4 o4 = *(const LAS f32x4*)(LG + rl * 32 + 4 * e4); const f32x4 b4 = *(const f32x4*)(rb + 4 * e4);
#pragma unroll
            for (int jj = 0; jj < 4; ++jj) { const float ov = o4[jj] * rs + b4[jj]; const int oe = 4 * e4 + jj;
#pragma unroll
                for (int i = 0; i < 4; ++i) { const int me = 4 * eg + i; rank[i] += (ov > mine[i] || (ov == mine[i] && oe < me)) ? 1 : 0; } } }
#pragma unroll
        for (int i = 0; i < 4; ++i) if (rank[i] < 4) { SEL[(rl * 4 + rank[i]) * 2] = mine[i]; ((LAS int*)SEL)[(rl * 4 + rank[i]) * 2 + 1] = 4 * eg + i; }
        asm volatile("s_waitcnt lgkmcnt(0)" ::: "memory");
        if (eg < 4) {
            const float v0 = SEL[(rl * 4 + 0) * 2], v1 = SEL[(rl * 4 + 1) * 2], v2 = SEL[(rl * 4 + 2) * 2], v3 = SEL[(rl * 4 + 3) * 2];
            const float e0 = 1.f, e1 = __expf(v1 - v0), e2 = __expf(v2 - v0), e3 = __expf(v3 - v0), den = (e0 + e1) + (e2 + e3);
            const float gsel = (eg == 0 ? e0 : eg == 1 ? e1 : eg == 2 ? e2 : e3) / den; const int isel = ((const LAS int*)SEL)[(rl * 4 + eg) * 2 + 1];
            sm[SM_TOPI + (row0 + rl) * 4 + eg] = isel; ((float*)sm)[SM_TOPG + (row0 + rl) * 4 + eg] = gsel;
            __hip_atomic_fetch_add(&hist[isel], 1u, __ATOMIC_RELAXED, __HIP_MEMORY_SCOPE_WORKGROUP);
        }
    }
#pragma unroll
    for (int rt = 0; rt < 2; ++rt) { const float rs = RS[32 * rt + r32];
#pragma unroll
        for (int s = 0; s < 8; ++s) { const v4u u = __builtin_bit_cast(v4u, a[rt][s]); const int k = k0 + 16 * s + 8 * hh;
            const f32x4 n0 = *(const f32x4*)(nfw + k), n1 = *(const f32x4*)(nfw + k + 4);
            typedef unsigned u32x2 __attribute__((ext_vector_type(2)));
            *(u32x2*)((unsigned char*)xn2 + (size_t)(row0 + 32 * rt + r32) * D_ + k) = (u32x2){
                pg8::pk4_fp8(rk::blo(u.x) * rs * n0[0], rk::bhi(u.x) * rs * n0[1], rk::blo(u.y) * rs * n0[2], rk::bhi(u.y) * rs * n0[3]),
                pg8::pk4_fp8(rk::blo(u.z) * rs * n1[0], rk::bhi(u.z) * rs * n1[1], rk::blo(u.w) * rs * n1[2], rk::bhi(u.w) * rs * n1[3])}; } }
    __syncthreads();
    { const int tid = wave * 64 + lane; if (tid < 32) sm[SM_HIST + bid * 32 + tid] = (int)hist[tid]; }
}
typedef __attribute__((address_space(4))) const char* kcptr;
template <class T> __device__ __forceinline__ T karg(int off) { kcptr k = (kcptr)__builtin_amdgcn_kernarg_segment_ptr(); asm volatile("" : "+s"(k)); return *(__attribute__((address_space(4))) const T*)(k + off); }
#define KA(f) karg<decltype(Args::f)>((int)offsetof(Args, f))
__global__ void __launch_bounds__(NTHR, 2) mega_fwd(Args a) {
    extern __shared__ __attribute__((aligned(16))) unsigned char lds_raw[];
    LAS unsigned char* lds = (LAS unsigned char*)lds_raw;
    volatile LAS unsigned* MISC = (volatile LAS unsigned*)(lds + MISC_OFF);
#define PHASE_IDS() int lane = hw_lane_id(); asm volatile("" : "+v"(lane)); const int wave = wave_s, tid = wave * 64 + lane; const int gw = bid * NWAVES + wave, NGW = G * NWAVES; (void)tid; (void)gw; (void)NGW
    const int bid = blockIdx.x, G = gridDim.x;
    const int wave_s = __builtin_amdgcn_readfirstlane((int)threadIdx.x >> 6);
    unsigned char* ws = KA(ws);
    unsigned* ctl = (unsigned*)(ws + WS_CTL);
    int* sm = (int*)(ws + WS_SMALL);
    for (int u = threadIdx.x; u < 64; u += NTHR) MISC[u] = 0u;
    __syncthreads();
    XcdBarrier bar = xcd_barrier_post(ctl + CW_BAR, MISC + 8); bar.w0 = wave_s;
    bf16_t* WIN = (bf16_t*)(ws + WS_WIN); bf16_t* WOUT = (bf16_t*)(ws + WS_WOUT); bf16_t* WGU = (bf16_t*)(ws + WS_WGU); bf16_t* WDN = (bf16_t*)(ws + WS_WDN);
    bf16_t* XN = (bf16_t*)(ws + WS_XN); bf16_t* LORA = (bf16_t*)(ws + WS_LORA); bf16_t* P = (bf16_t*)(ws + WS_P); bf16_t* YMIX = (bf16_t*)(ws + WS_YMIX);

    for (int rep = 0; rep < REP_P0; ++rep) {
        PHASE_IDS();
        LAS float* scr = (LAS float*)(lds + wave * 16384);
        constexpr int I_IN = (D_ / 64) * (INC / 32), I_OUT = (D_ / 64) * (D_ / 32), I_GU = (D_ / 64) * (2 * FF / 32), I_DN = (FF / 64) * (D_ / 32);
        constexpr int NGU0 = E_ * I_GU - P3_ITEMS;
        constexpr int NITEMS = I_IN + I_OUT + NGU0 + E_ * I_DN - TAIL_ITEMS;
        const float* w_in_ = KA(w_in); const float* w_out_ = KA(w_out); const float* gu_w_ = KA(gu_w); const float* dn_w_ = KA(dn_w);
        for (int it = gw; it < NITEMS; it += NGW) {
            int r = it;
            if (r < I_IN) { transpose_item(w_in_, D_, INC, WIN, MapPlain{0}, scr, r, lane); continue; } r -= I_IN;
            if (r < I_OUT) { transpose_item(w_out_, D_, D_, WOUT, MapPlain{0}, scr, r, lane); continue; } r -= I_OUT;
            if (r < NGU0) { const int e = r / I_GU; transpose_item8(gu_w_ + (size_t)e * D_ * 2 * FF, D_, 2 * FF, (unsigned char*)WGU, MapGU{e}, scr, r % I_GU, lane); continue; } r -= NGU0;
            { const int e = r / I_DN; transpose_item8(dn_w_ + (size_t)e * FF * D_, FF, D_, (unsigned char*)WDN, MapDN{e}, scr, r % I_DN, lane); }
        }
        { const float* x_ = KA(x); const float* nmw_ = KA(nmw);
          for (int m = gw; m < T_; m += 2 * NGW) {
              const f32x4* xa = (const f32x4*)(x_ + (size_t)m * D_) + lane; const f32x4* xb = (const f32x4*)(x_ + (size_t)(m + NGW) * D_) + lane; const f32x4* wr = (const f32x4*)nmw_ + lane;
              f32x4 va[4], vb[4]; float sa = 0.f, sb = 0.f;
#pragma unroll
              for (int j = 0; j < 4; ++j) { va[j] = __builtin_nontemporal_load(xa + 64 * j); vb[j] = __builtin_nontemporal_load(xb + 64 * j); }
#pragma unroll
              for (int j = 0; j < 4; ++j) { sa += (va[j].x * va[j].x + va[j].y * va[j].y) + (va[j].z * va[j].z + va[j].w * va[j].w); sb += (vb[j].x * vb[j].x + vb[j].y * vb[j].y) + (vb[j].z * vb[j].z + vb[j].w * vb[j].w); }
              sa = rk::wsum(sa); sb = rk::wsum(sb);
              const float ra = rsqrtf(sa * (1.f / D_) + 1e-5f), rb2 = rsqrtf(sb * (1.f / D_) + 1e-5f);
              unsigned long long* oa = (unsigned long long*)(XN + (size_t)m * D_) + lane; unsigned long long* ob = (unsigned long long*)(XN + (size_t)(m + NGW) * D_) + lane;
#pragma unroll
              for (int j = 0; j < 4; ++j) { const f32x4 ww = wr[64 * j];
                  oa[64 * j] = (unsigned long long)pk2(va[j].x * ra * ww.x, va[j].y * ra * ww.y) | ((unsigned long long)pk2(va[j].z * ra * ww.z, va[j].w * ra * ww.w) << 32);
                  ob[64 * j] = (unsigned long long)pk2(vb[j].x * rb2 * ww.x, vb[j].y * rb2 * ww.y) | ((unsigned long long)pk2(vb[j].z * rb2 * ww.z, vb[j].w * rb2 * ww.w) << 32); }
          } }
        { const float* rw_ = KA(rw); const float* nfw_ = KA(nfw); bf16_t* W2 = (bf16_t*)(ws + WS_W2);
          for (int idx = bid * NTHR + tid; idx < 32 * 1024; idx += G * NTHR) { const int e = idx >> 10, k = idx & 1023; const float v = rw_[k * 32 + e] * nfw_[k];
              const unsigned hb = f2bf(v); const float hf = bf2f((unsigned short)hb); W2[e * 1024 + k] = (bf16_t)hb; W2[(32 + e) * 1024 + k] = (bf16_t)f2bf(v - hf); } }
        const float* wdu_ = KA(wdu); const float* wiu_ = KA(wiu); const float* wgu_ = KA(wgu);
        for (int idx = bid * NTHR + tid; idx < 512 * 256; idx += G * NTHR) {
            const int c = idx >> 8, j = idx & 255;
            if (j < 64) LORA[c * 64 + j] = (bf16_t)f2bf(wdu_[j * 512 + c]);
            else if (j < 128) LORA[512 * 64 + c * 64 + (j - 64)] = (bf16_t)f2bf(wiu_[(j - 64) * 512 + c]);
            else LORA[2 * 512 * 64 + c * 128 + (j - 128)] = (bf16_t)f2bf(wgu_[(j - 128) * 512 + c]);
        }
    }
    xcd_barrier(bar);
    for (int rep = 0; rep < REP_G1; ++rep) {
        pg8::Gemm g{XN, WIN, T_, INC, D_}; pg8::StaticOrder S; S.init(T_, INC, G, bid);
        pg8::EpiBf16 E{P, INC};
        pg8::gemm_phase<pg8::EpiBf16, pg8::StaticOrder, true, true>(lds, g, S, E, wave_s);
        if (bid >= 64) {
            PHASE_IDS();
            constexpr int I_DN = (FF / 64) * (D_ / 32); const float* dn_w_ = KA(dn_w); LAS float* scr = (LAS float*)(lds + wave * 16384);
            const int tw = (bid - 64) * NWAVES + wave;
            for (int it = tw; it < TAIL_ITEMS; it += 192 * NWAVES) { const int r = E_ * I_DN - TAIL_ITEMS + it; const int e = r / I_DN;
                transpose_item8(dn_w_ + (size_t)e * FF * D_, FF, D_, (unsigned char*)WDN, MapDN{e}, scr, r % I_DN, lane); }
        }
    }
    xcd_barrier(bar);
    {
        rk::R1Args r{P, KA(mu), KA(w0), KA(a0), KA(k_k), KA(k_a), KA(r_k), LORA, LORA + 512 * 64, ws + WS_UNITS, (float*)(ws + WS_GAM), (float*)(ws + WS_BON), nullptr};
        for (int bc = bid; bc < 256; bc += G) rk::r1_block(r, lds, bc, wave_s);
    }
    xcd_barrier(bar);
    for (int rep = 0; rep < REP_P3; ++rep) {
        PHASE_IDS();
        if (bid < 16) { rk::R2Args r{ws + WS_UNITS, (const float*)(ws + WS_GAM), ws + WS_ZS}; rk::r2_block(r, lds, bid, wave_s); if (REP_R2 > 1) rk::r2_block(r, lds, bid, wave_s); }
        else {
            conv_rows(P, KA(conv_w), YMIX, (bid - 16) * NWAVES + wave, (G - 16) * NWAVES, lane);
            constexpr int I_GU = (D_ / 64) * (2 * FF / 32); const float* gu_w_ = KA(gu_w); LAS float* scr = (LAS float*)(lds + wave * 16384);
            for (int it = (bid - 16) * NWAVES + wave; it < P3_ITEMS; it += (G - 16) * NWAVES) { const int r = E_ * I_GU - P3_ITEMS + it; const int e = r / I_GU;
                transpose_item8(gu_w_ + (size_t)e * D_ * 2 * FF, D_, 2 * FF, (unsigned char*)WGU, MapGU{e}, scr, r % I_GU, lane); }
        }
    }
    xcd_barrier(bar);
    {
        rk::R3Args r{P, KA(mu), KA(lnw), KA(lnb), LORA + 2 * 512 * 64, ws + WS_UNITS, ws + WS_ZS, (const float*)(ws + WS_BON), YMIX, nullptr, nullptr};
        for (int bc = bid; bc < 256; bc += G) { rk::r3_block(r, lds, bc, wave_s); __syncthreads(); }
    }
    xcd_barrier(bar);
    for (int rep = 0; rep < REP_G1; ++rep) {
        pg8::Gemm g{YMIX, WOUT, T_, D_, D_}; pg8::StaticOrder S; S.init(T_, D_, G, bid);
        pg8::EpiResBf16 E{KA(x), (bf16_t*)(ws + WS_H1), D_};
        pg8::gemm_phase<pg8::EpiResBf16, pg8::StaticOrder, true, true>(lds, g, S, E, wave_s);
    }
    xcd_barrier(bar);
    { PHASE_IDS();
      router_block((const bf16_t*)(ws + WS_H1), (const bf16_t*)(ws + WS_W2), KA(nfw), KA(rb), XN, sm, lds, bid, wave, lane);
    }
    xcd_barrier(bar);
    LAS int* tl = (LAS int*)(lds + 131072);
    {
        PHASE_IDS();
        LAS int* part = tl + 512;
        { const int e = tid & 31, pt = tid >> 5; int sb = 0, sa = 0;
          for (int w2 = pt * 16; w2 < pt * 16 + 16; ++w2) { const int v = sm[SM_HIST + w2 * 32 + e]; sa += v; if (w2 < bid) sb += v; }
          part[pt * 64 + e] = sb; part[pt * 64 + 32 + e] = sa; }
        __syncthreads();
        if (tid < 32) { int sb = 0, sa = 0; for (int pt = 0; pt < 16; ++pt) { sb += part[pt * 64 + tid]; sa += part[pt * 64 + 32 + tid]; } tl[416 + tid] = sb; tl[448 + tid] = sa; tl[480 + tid] = 0; }
        __syncthreads();
        if (tid == 0) { int acc = 0; for (int e = 0; e < E_; ++e) { const int tiles = (tl[448 + e] + 255) / 256; tl[336 + e] = acc * 256; tl[384 + e] = acc * 256 + tl[416 + e]; for (int t = 0; t < tiles; ++t) tl[acc + t] = e; acc += tiles; } tl[320] = acc; }
        __syncthreads();
        if (bid < E_) { const int b0 = tl[336 + bid], cnt = tl[448 + bid], end = b0 + (cnt + 255) / 256 * 256;
            for (int i = b0 + cnt + tid; i < end; i += 512) sm[SM_ROWTOK + i] = 0; }
        {
            if (tid < 256) { const int pidx = 256 * bid + tid; const int e = sm[SM_TOPI + pidx];
                const int pos = tl[384 + e] + __hip_atomic_fetch_add(tl + 480 + e, 1, __ATOMIC_RELAXED, __HIP_MEMORY_SCOPE_WORKGROUP);
                ((float*)sm)[SM_ROWGATE + pos] = ((const float*)sm)[SM_TOPG + pidx]; sm[SM_PAIRROW + pidx] = pos; sm[SM_ROWTOK + pos] = pidx >> 2; }
        }
    }
    xcd_barrier(bar);
    const int nt = __builtin_amdgcn_readfirstlane(tl[320]);
    for (int rep = 0; rep < REP_MOE; ++rep) {
        pg8::Gemm g{XN, WGU, ROWS_PAD, E_ * 2 * FF, D_ / 2};
        pg8::MoeOrder S{tl, nt, 8, bid};
        pg8::EpiSwiglu8 E{ws + WS_ACT, KA(gu_b)};
        pg8::gemm_phase<pg8::EpiSwiglu8, pg8::MoeOrder, true, true, true, true>(lds, g, S, E, wave_s, sm + SM_ROWTOK);
    }
    xcd_barrier(bar);
    for (int rep = 0; rep < REP_MOE; ++rep) {
        pg8::Gemm g{(const bf16_t*)(ws + WS_ACT), WDN, ROWS_PAD, E_ * D_, FF / 2};
        pg8::MoeOrder S{tl, nt, 4, bid};
        pg8::EpiDown8 E{ws + WS_YB, KA(dn_b), (const float*)(sm + SM_ROWGATE)};
        pg8::gemm_phase<pg8::EpiDown8, pg8::MoeOrder, true, true, true>(lds, g, S, E, wave_s);
    }
    xcd_barrier(bar);
    for (int rep = 0; rep < REP_P10; ++rep) { PHASE_IDS(); const float* nfin_ = KA(nfinal); float* out_ = KA(out); for (int row = gw; row < T_; row += NGW) final_row((const bf16_t*)(ws + WS_H1), ws + WS_YB, nfin_, out_, row, lane, sm); }
}
}

extern "C" void kernel_launch(void* const* d_in, const int* in_sizes, int n_in, void* d_out, int out_size, void* d_ws, size_t ws_size, hipStream_t stream) {
    static bool inited = false;
    if (!inited) { (void)hipFuncSetAttribute((const void*)mega_fwd, hipFuncAttributeMaxDynamicSharedMemorySize, LDS_BYTES); inited = true; }
    Args a{};
    a.x = (const float*)d_in[0]; a.nmw = (const float*)d_in[1]; a.w_in = (const float*)d_in[2]; a.conv_w = (const float*)d_in[3]; a.mu = (const float*)d_in[4]; a.w0 = (const float*)d_in[5];
    a.wdu = (const float*)d_in[6]; a.a0 = (const float*)d_in[7]; a.wiu = (const float*)d_in[8]; a.wgu = (const float*)d_in[9]; a.k_k = (const float*)d_in[10]; a.k_a = (const float*)d_in[11];
    a.r_k = (const float*)d_in[12]; a.lnw = (const float*)d_in[13]; a.lnb = (const float*)d_in[14]; a.w_out = (const float*)d_in[15]; a.nfw = (const float*)d_in[16]; a.rw = (const float*)d_in[17];
    a.rb = (const float*)d_in[18]; a.gu_w = (const float*)d_in[19]; a.gu_b = (const float*)d_in[20]; a.dn_w = (const float*)d_in[21]; a.dn_b = (const float*)d_in[22]; a.nfinal = (const float*)d_in[23];
    a.out = (float*)d_out; a.ws = (unsigned char*)d_ws;
    (void)hipMemsetAsync((unsigned char*)d_ws + WS_CTL, 0, 1 << 20, stream);
    mega_fwd<<<GRID, NTHR, LDS_BYTES, stream>>>(a);
}
```

```cpp
#include <hip/hip_runtime.h>
#include <cstdint>
#include <cstdio>
__device__ __forceinline__ int hw_lane_id() { return (int)__builtin_amdgcn_mbcnt_hi(0xffffffffu, __builtin_amdgcn_mbcnt_lo(0xffffffffu, 0u)); }
namespace pg8 {
#define PG8_LAS __attribute__((address_space(3)))
typedef unsigned short bf16_t;
typedef short bf16x8 __attribute__((ext_vector_type(8)));
typedef float f32x4 __attribute__((ext_vector_type(4)));
typedef unsigned u32x4 __attribute__((ext_vector_type(4)));
constexpr int BM = 256, BK = 64, HALF = 128, HTB = HALF * BK * 2  , STAGE_BYTES = 8 * HTB, NXCD = 8, WGM = 8;

__host__ __device__ __forceinline__ int lds_byte(int r, int c) { const int st = (r >> 4) * 2 + (c >> 5), rr = r & 15, cc = c & 31, ob = rr * 64 + cc * 2; return st * 1024 + (ob ^ (((ob >> 9) & 1) << 5)); }
__host__ __device__ __forceinline__ void stage_rc(int b, int& R, int& C) { const int st = b / 1024, sb = b % 1024, swz = sb ^ (((sb >> 9) & 1) << 5); R = (st >> 1) * 16 + swz / 64; C = (st & 1) * 32 + (swz % 64) / 2; }
__host__ __device__ __forceinline__ int perm32(int rho) { const int n = rho >> 4, i = rho & 15; return 8 * (i >> 2) + 4 * n + (i & 3); }

struct Unit { int pm, pn; };
struct Gemm { const bf16_t* A; const bf16_t* Bt; int M, N, K; };

struct StaticOrder {
    int nM, nN, nwg, G, c;
    __host__ __device__ void init(int M, int N, int G_, int c_) { nM = M / BM; nN = N / BM; nwg = nM * nN; G = G_; c = c_; }
    __host__ __device__ bool next(int i, Unit& u) const {
        const long L = (long)i * G + c; if (L >= nwg) return false;
        int wgid = (int)L; { const int q = nwg / NXCD, r = nwg % NXCD, xcd = wgid % NXCD, off = wgid / NXCD; wgid = (xcd < r ? xcd * (q + 1) : r * (q + 1) + (xcd - r) * q) + off; }
        const int nig = WGM * nN, gid = wgid / nig, fm = gid * WGM, gsz = (nM - fm) < WGM ? (nM - fm) : WGM;
        u.pm = fm + ((wgid % nig) % gsz); u.pn = (wgid % nig) / gsz; return true;
    }
    __device__ __forceinline__ void a_ready(const Unit&) const {}
    __device__ __forceinline__ void done(const Unit&) const {}
};

typedef float f32x2_t __attribute__((ext_vector_type(2))); typedef __bf16 bf16x2_t __attribute__((ext_vector_type(2)));
__device__ __forceinline__ unsigned cvt_pk_bf16(float lo, float hi) { f32x2_t v = {lo, hi}; bf16x2_t b = __builtin_convertvector(v, bf16x2_t); return __builtin_bit_cast(unsigned, b); }
typedef float f32x2 __attribute__((ext_vector_type(2)));
struct EpiBf16 {
    static constexpr bool PERM = true, AFTER_DRAIN = false;
    bf16_t* O; int ldc;
    __device__ __forceinline__ void operator()(const f32x4 (&acc)[2][2][4][2], const Unit& u, int wr, int wc, int fr, int fq) const {
        const int row0 = u.pm * BM + wr * 64 + fr, col0 = u.pn * BM + wc * 32 + 8 * fq;
#pragma unroll
        for (int ai = 0; ai < 2; ++ai)
#pragma unroll
            for (int m = 0; m < 4; ++m) { bf16_t* rowp = O + (size_t)(row0 + ai * HALF + m * 16) * ldc + col0;
#pragma unroll
                for (int bj = 0; bj < 2; ++bj) { const f32x4 v0 = acc[ai][bj][m][0], v1 = acc[ai][bj][m][1];
                    u32x4 w; w.x = cvt_pk_bf16(v0[0], v0[1]); w.y = cvt_pk_bf16(v0[2], v0[3]); w.z = cvt_pk_bf16(v1[0], v1[1]); w.w = cvt_pk_bf16(v1[2], v1[3]);
                    *(u32x4*)(rowp + bj * HALF) = w; } }
    }
};
struct EpiResBf16 {
    static constexpr bool PERM = true, AFTER_DRAIN = false;
    const float* base; bf16_t* O; int ldc;
    __device__ __forceinline__ void operator()(const f32x4 (&acc)[2][2][4][2], const Unit& u, int wr, int wc, int fr, int fq) const {
        const int row0 = u.pm * BM + wr * 64 + fr, col0 = u.pn * BM + wc * 32 + 8 * fq;
#pragma unroll
        for (int ai = 0; ai < 2; ++ai)
#pragma unroll
            for (int m = 0; m < 4; ++m) { const size_t off = (size_t)(row0 + ai * HALF + m * 16) * ldc + col0;
#pragma unroll
                for (int bj = 0; bj < 2; ++bj) { const f32x4 b0 = *(const f32x4*)(base + off + bj * HALF), b1 = *(const f32x4*)(base + off + bj * HALF + 4);
                    const f32x4 v0 = acc[ai][bj][m][0] + b0, v1 = acc[ai][bj][m][1] + b1;
                    u32x4 w; w.x = cvt_pk_bf16(v0[0], v0[1]); w.y = cvt_pk_bf16(v0[2], v0[3]); w.z = cvt_pk_bf16(v1[0], v1[1]); w.w = cvt_pk_bf16(v1[2], v1[3]);
                    *(u32x4*)(O + off + bj * HALF) = w; }
                asm volatile("" ::: "memory"); }
    }
};
struct EpiResXn {
    static constexpr bool PERM = true, AFTER_DRAIN = false;
    const bf16_t* xn; const float* irs; const float* nw; bf16_t* O; int ldc;
    __device__ __forceinline__ void operator()(const f32x4 (&acc)[2][2][4][2], const Unit& u, int wr, int wc, int fr, int fq) const {
        const int row0 = u.pm * BM + wr * 64 + fr, col0 = u.pn * BM + wc * 32 + 8 * fq;
        f32x4 iw[2][2];
#pragma unroll
        for (int bj = 0; bj < 2; ++bj)
#pragma unroll
            for (int hx = 0; hx < 2; ++hx) { const f32x4 w4 = *(const f32x4*)(nw + col0 + bj * HALF + 4 * hx);
                iw[bj][hx] = (f32x4){__builtin_amdgcn_rcpf(w4[0]), __builtin_amdgcn_rcpf(w4[1]), __builtin_amdgcn_rcpf(w4[2]), __builtin_amdgcn_rcpf(w4[3])}; }
#pragma unroll
        for (int ai = 0; ai < 2; ++ai) {
            u32x4 xq[4][2]; float ir[4];
#pragma unroll
            for (int m = 0; m < 4; ++m) { const int row = row0 + ai * HALF + m * 16; const size_t off = (size_t)row * ldc + col0; ir[m] = irs[row];
#pragma unroll
                for (int bj = 0; bj < 2; ++bj) xq[m][bj] = *(const u32x4*)(xn + off + bj * HALF); }
            asm volatile("" ::: "memory");
#pragma unroll
            for (int m = 0; m < 4; ++m) { const size_t off = (size_t)(row0 + ai * HALF + m * 16) * ldc + col0;
#pragma unroll
                for (int bj = 0; bj < 2; ++bj) { const u32x4 q = xq[m][bj];
                    const f32x4 x0 = {__builtin_bit_cast(float, q.x << 16), __builtin_bit_cast(float, q.x & 0xffff0000u), __builtin_bit_cast(float, q.y << 16), __builtin_bit_cast(float, q.y & 0xffff0000u)};
                    const f32x4 x1 = {__builtin_bit_cast(float, q.z << 16), __builtin_bit_cast(float, q.z & 0xffff0000u), __builtin_bit_cast(float, q.w << 16), __builtin_bit_cast(float, q.w & 0xffff0000u)};
                    const f32x4 v0 = acc[ai][bj][m][0] + x0 * iw[bj][0] * ir[m], v1 = acc[ai][bj][m][1] + x1 * iw[bj][1] * ir[m];
                    u32x4 w; w.x = cvt_pk_bf16(v0[0], v0[1]); w.y = cvt_pk_bf16(v0[2], v0[3]); w.z = cvt_pk_bf16(v1[0], v1[1]); w.w = cvt_pk_bf16(v1[2], v1[3]);
                    *(u32x4*)(O + off + bj * HALF) = w; } }
            asm volatile("" ::: "memory");
        }
    }
};
__device__ __forceinline__ unsigned pk4_fp8(float a, float b, float c, float d) { int w = 0; w = __builtin_amdgcn_cvt_pk_fp8_f32(a, b, w, false); w = __builtin_amdgcn_cvt_pk_fp8_f32(c, d, w, true); return (unsigned)w; }
struct EpiSwiglu8 {
    static constexpr bool PERM = true, AFTER_DRAIN = false;
    unsigned char* act; const float* gu_b;
    __device__ __forceinline__ void with_bias(const f32x4 (&acc)[2][2][4][2], const Unit& u, int wr, int wc, int fr, int fq, const float (&b)[16]) const {
        typedef float f2 __attribute__((ext_vector_type(2)));
        const int j = u.pn & 7;
        const int row0 = u.pm * BM + wr * 64 + fr, a0 = j * 128 + wc * 32 + 8 * fq;
        const f2 bg[4] = {{b[0], b[2]}, {b[4], b[6]}, {b[8], b[10]}, {b[12], b[14]}};
        const f2 bl[4] = {{b[1] + 1.f, b[3] + 1.f}, {b[5] + 1.f, b[7] + 1.f}, {b[9] + 1.f, b[11] + 1.f}, {b[13] + 1.f, b[15] + 1.f}};
        const f2 sc = {0.03125f, 0.03125f}, one = {1.f, 1.f}, c1 = {-1.702f * 1.4426950408889634f, -1.702f * 1.4426950408889634f};
#pragma unroll
        for (int ai = 0; ai < 2; ++ai)
#pragma unroll
            for (int m = 0; m < 4; ++m) {
                f2 o[4];
#pragma unroll
                for (int p = 0; p < 4; ++p) {
                    const int n = p >> 1, i = (p & 1) * 2;
                    f2 hg = (f2){acc[ai][0][m][n][i], acc[ai][0][m][n][i + 1]} * sc + bg[p];
                    f2 hl = (f2){acc[ai][1][m][n][i], acc[ai][1][m][n][i + 1]} * sc + bl[p];
                    hg.x = fminf(hg.x, 7.f); hg.y = fminf(hg.y, 7.f);
                    hl.x = __builtin_amdgcn_fmed3f(hl.x, -6.f, 8.f); hl.y = __builtin_amdgcn_fmed3f(hl.y, -6.f, 8.f);
                    const f2 t = hg * c1;
                    f2 ex; ex.x = __builtin_amdgcn_exp2f(t.x); ex.y = __builtin_amdgcn_exp2f(t.y);
                    const f2 d = ex + one;
                    f2 r; r.x = __builtin_amdgcn_rcpf(d.x); r.y = __builtin_amdgcn_rcpf(d.y);
                    o[p] = (hg * r) * hl;
                }
                typedef unsigned u32x2 __attribute__((ext_vector_type(2)));
                *(u32x2*)(act + (size_t)(row0 + ai * HALF + m * 16) * 1024 + a0) = (u32x2){pk4_fp8(o[0].x, o[0].y, o[1].x, o[1].y), pk4_fp8(o[2].x, o[2].y, o[3].x, o[3].y)};
            }
    }
};
struct EpiDown8 {
    static constexpr bool PERM = true, AFTER_DRAIN = false;
    unsigned char* yb; const float* dn_b; const float* gate;
    __device__ __forceinline__ void with_ops(const f32x4 (&acc)[2][2][4][2], const Unit& u, int wr, int wc, int fr, int fq, const float (&b)[16], const float (&g)[8]) const {
        const int j = u.pn & 3;
        const int row0 = u.pm * BM + wr * 64 + fr, col0 = j * 256 + wc * 64 + 16 * fq;
#pragma unroll
        for (int ai = 0; ai < 2; ++ai)
#pragma unroll
            for (int m = 0; m < 4; ++m) { const int row = row0 + ai * HALF + m * 16; const float gt = g[4 * ai + m], gb = gt * 32.f;
                u32x4 w;
#pragma unroll
                for (int bj = 0; bj < 2; ++bj) {
                    const f32x4 bv0 = {b[8 * bj + 0], b[8 * bj + 1], b[8 * bj + 2], b[8 * bj + 3]}, bv1 = {b[8 * bj + 4], b[8 * bj + 5], b[8 * bj + 6], b[8 * bj + 7]};
                    const f32x4 v0 = acc[ai][bj][m][0] * gt + bv0 * gb, v1 = acc[ai][bj][m][1] * gt + bv1 * gb;
                    w[2 * bj] = pk4_fp8(v0[0], v0[1], v0[2], v0[3]); w[2 * bj + 1] = pk4_fp8(v1[0], v1[1], v1[2], v1[3]); }
                *(u32x4*)(yb + (size_t)row * 1024 + col0) = w; }
    }
};
struct MoeOrder {
    const PG8_LAS int* tile_e; int nt, NT, c;
    __device__ __forceinline__ bool next(int i, Unit& u) const {
        const int v = c & 7, s = c >> 3;
        const int t0 = (v * nt) >> 3, t1 = ((v + 1) * nt) >> 3, n = t1 - t0;
        const int q = i * 32 + s;
        if (q >= n * NT) return false;
        const int gl = 1 * NT, g = q / gl, r = q - g * gl, fm = t0 + 1 * g, gsz = (t1 - fm) < 1 ? (t1 - fm) : 1;
        const int j = r / gsz, tile = fm + (r - j * gsz);
        u.pm = tile; u.pn = __builtin_amdgcn_readfirstlane(tile_e[tile]) * NT + j; return true;
    }
    __device__ __forceinline__ void a_ready(const Unit&) const {}
    __device__ __forceinline__ void done(const Unit&) const {}
};

constexpr int RT_LDS = 131072 + 8192 + 16384;
constexpr int EPI_LDS = 131072 + 8192;
template <class Epi> struct EpiPre {
    __device__ __forceinline__ void load(const Epi&, const Unit&, int, int, int, PG8_LAS unsigned char*, int) {}
    __device__ __forceinline__ void load_next(const Epi&, const Unit&, int, int, int, PG8_LAS unsigned char*, int) {}
    __device__ __forceinline__ void run(const Epi& E, const f32x4 (&acc)[2][2][4][2], const Unit& u, int wr, int wc, int fr, int fq, PG8_LAS unsigned char*, int) { E(acc, u, wr, wc, fr, fq); }
};
__device__ __forceinline__ void dma4(const float* g, PG8_LAS unsigned char* l) { __builtin_amdgcn_global_load_lds((const unsigned*)g, (PG8_LAS unsigned*)l, 4, 0, 0); }
template <> struct EpiPre<EpiSwiglu8> {
    int par;
    __device__ __forceinline__ void fetch(const EpiSwiglu8& E, const Unit& u, int wc, int lane, PG8_LAS unsigned char* lds, int wid, int p) const {
        const int e = u.pn >> 3, j = u.pn & 7;
        dma4(E.gu_b + (size_t)e * 2048 + 2 * (j * 128 + wc * 32 + 8 * (lane >> 4)) + (lane & 15), lds + EPI_LDS + (p * 8 + wid) * 1024);
    }
    __device__ __forceinline__ void load(const EpiSwiglu8& E, const Unit& u, int, int wc, int lane, PG8_LAS unsigned char* lds, int wid) { par = 0; fetch(E, u, wc, lane, lds, wid, 0); }
    __device__ __forceinline__ void load_next(const EpiSwiglu8& E, const Unit& u, int, int wc, int lane, PG8_LAS unsigned char* lds, int wid) { fetch(E, u, wc, lane, lds, wid, par ^ 1); }
    __device__ __forceinline__ void run(const EpiSwiglu8& E, const f32x4 (&acc)[2][2][4][2], const Unit& u, int wr, int wc, int fr, int fq, PG8_LAS unsigned char* lds, int wid) {
        const PG8_LAS f32x4* s = (const PG8_LAS f32x4*)(lds + EPI_LDS + (par * 8 + wid) * 1024 + fq * 64);
        const f32x4 b0 = s[0], b1 = s[1], b2 = s[2], b3 = s[3];
        const float b[16] = {b0[0], b0[1], b0[2], b0[3], b1[0], b1[1], b1[2], b1[3], b2[0], b2[1], b2[2], b2[3], b3[0], b3[1], b3[2], b3[3]};
        E.with_bias(acc, u, wr, wc, fr, fq, b);
        par ^= 1;
    }
};
template <> struct EpiPre<EpiDown8> {
    int par;
    __device__ __forceinline__ void fetch(const EpiDown8& E, const Unit& u, int wr, int wc, int lane, PG8_LAS unsigned char* lds, int wid, int p) const {
        const int e = u.pn >> 2, j = u.pn & 3; PG8_LAS unsigned char* slot = lds + EPI_LDS + (p * 8 + wid) * 1024;
        dma4(E.dn_b + (size_t)e * 1024 + j * 256 + wc * 64 + lane, slot);
#pragma unroll
        for (int k = 0; k < 2; ++k) { const int am = (lane >> 4) + 4 * k; dma4(E.gate + u.pm * BM + wr * 64 + (lane & 15) + (am >> 2) * HALF + (am & 3) * 16, slot + 256 + 256 * k); }
    }
    __device__ __forceinline__ void load(const EpiDown8& E, const Unit& u, int wr, int wc, int lane, PG8_LAS unsigned char* lds, int wid) { par = 0; fetch(E, u, wr, wc, lane, lds, wid, 0); }
    __device__ __forceinline__ void load_next(const EpiDown8& E, const Unit& u, int wr, int wc, int lane, PG8_LAS unsigned char* lds, int wid) { fetch(E, u, wr, wc, lane, lds, wid, par ^ 1); }
    __device__ __forceinline__ void run(const EpiDown8& E, const f32x4 (&acc)[2][2][4][2], const Unit& u, int wr, int wc, int fr, int fq, PG8_LAS unsigned char* lds, int wid) {
        const PG8_LAS unsigned char* slot = lds + EPI_LDS + (par * 8 + wid) * 1024;
        const PG8_LAS f32x4* s = (const PG8_LAS f32x4*)(slot + fq * 64);
        const f32x4 b0 = s[0], b1 = s[1], b2 = s[2], b3 = s[3];
        const float b[16] = {b0[0], b0[1], b0[2], b0[3], b1[0], b1[1], b1[2], b1[3], b2[0], b2[1], b2[2], b2[3], b3[0], b3[1], b3[2], b3[3]};
        float g[8];
#pragma unroll
        for (int am = 0; am < 8; ++am) g[am] = *(const PG8_LAS float*)(slot + 256 + 256 * (am >> 2) + (fr + 16 * (am & 3)) * 4);
        E.with_ops(acc, u, wr, wc, fr, fq, b, g);
        par ^= 1;
    }
};
typedef int v8i32 __attribute__((ext_vector_type(8)));
typedef int v4i32 __attribute__((ext_vector_type(4)));
__device__ __forceinline__ v8i32 ld8(const PG8_LAS unsigned char* p, int kst) { const v4i32 a = *(const PG8_LAS v4i32*)p, b = *(const PG8_LAS v4i32*)(p + kst); return __builtin_shufflevector(a, b, 0, 1, 2, 3, 4, 5, 6, 7); }
__device__ __forceinline__ bf16x8 flo(const v8i32& f) { return __builtin_bit_cast(bf16x8, (v4i32)__builtin_shufflevector(f, f, 0, 1, 2, 3)); }
__device__ __forceinline__ bf16x8 fhi(const v8i32& f) { return __builtin_bit_cast(bf16x8, (v4i32)__builtin_shufflevector(f, f, 4, 5, 6, 7)); }
template <class Epi, class Sched, bool ALIGN_EPI = false, bool SP2 = false, bool FP8 = false, bool GATHER = false>
__device__ __forceinline__ void gemm_phase(PG8_LAS unsigned char* lds, const Gemm g, const Sched& S, const Epi& E, const int wid_in, const int* rowtok = nullptr) {
    static_assert(!GATHER || SP2, "gather is wired into the SP2 schedule only");
    int lane = hw_lane_id(); asm volatile("" : "+v"(lane));
    const int wid = wid_in, tid = wid * 64 + lane, wr = wid >> 2, wc = wid & 3, fr = lane & 15, fq = lane >> 4;
    int K = g.K; asm volatile("" : "+s"(K));
    const int nt = K / BK;
    unsigned voffA[2], voffB[2];
#pragma unroll
    for (int i = 0; i < 2; ++i) { int R, C; stage_rc(tid * 16 + i * 8192, R, C); const int Rb = Epi::PERM ? ((R & ~31) + perm32(R & 31)) : R;
        voffA[i] = (unsigned)(R * K + C) * 2u; voffB[i] = (unsigned)(Rb * K + C) * 2u; }
    unsigned gA[4] = {0u, 0u, 0u, 0u};
    const unsigned gcol = voffA[0] - (unsigned)(((wid >> 1) * 16 + (lane >> 2)) * K) * 2u;
    PG8_LAS unsigned char* rts = lds + RT_LDS + wid * 256;
    const size_t kstep = (size_t)(BK * 2);
    const size_t hstep = (size_t)HALF * K * 2;
    const size_t tstep = 2 * hstep;
    const unsigned ldsw = (unsigned)wid * 1024u;
    const int aoff = lds_byte(wr * 64 + fr, fq * 8), boff = lds_byte(wc * 32 + fr, fq * 8);
    constexpr int KST = 1024;
    int scl = 0x7F7F7F7F; asm volatile("" : "+v"(scl));
#define PG8_SA(b, h) (((b) * 2 + (h)) * HTB)
#define PG8_SB(b, h) ((4 + (b) * 2 + (h)) * HTB)
#define PG8_STAGE(bufoff, gbase, voff) do { _Pragma("unroll") for (int _i = 0; _i < 2; ++_i) \
        __builtin_amdgcn_global_load_lds((const unsigned*)((const char*)(gbase) + (voff)[_i]), (PG8_LAS unsigned*)(lds + (bufoff) + ldsw + _i * 8192), 16, 0, 0); } while (0)
#define PG8_STAGE_A(bufoff, gbase, h) do { if constexpr (GATHER) { _Pragma("unroll") for (int _i = 0; _i < 2; ++_i) \
        __builtin_amdgcn_global_load_lds((const unsigned*)((const char*)(gbase) + gA[2 * (h) + _i]), (PG8_LAS unsigned*)(lds + (bufoff) + ldsw + _i * 8192), 16, 0, 0); } \
        else PG8_STAGE(bufoff, (gbase) + (h) * hstep, voffA); } while (0)
#define PG8_LDA(dst, b, h) do { _Pragma("unroll") for (int m = 0; m < 4; ++m) dst[m] = ld8(lds + PG8_SA(b, h) + aoff + m * 2048, KST); } while (0)
#define PG8_LDB(dst, b, h) do { _Pragma("unroll") for (int n = 0; n < 2; ++n) dst[n] = ld8(lds + PG8_SB(b, h) + boff + n * 2048, KST); } while (0)
#define PG8_MMA(ai, bj, At, Bt) do { __builtin_amdgcn_s_setprio(1); if constexpr (FP8) { _Pragma("unroll") for (int m = 0; m < 4; ++m) _Pragma("unroll") for (int n = 0; n < 2; ++n) \
        asm volatile("v_mfma_scale_f32_16x16x128_f8f6f4 %0, %1, %2, %0, %3, %3 op_sel_hi:[0,0,0]" : "+v"(acc[ai][bj][m][n]) : "v"(Bt[n]), "v"(At[m]), "v"(scl)); } else { \
        _Pragma("unroll") for (int m = 0; m < 4; ++m) _Pragma("unroll") for (int n = 0; n < 2; ++n) { \
        acc[ai][bj][m][n] = __builtin_amdgcn_mfma_f32_16x16x32_bf16(flo(Bt[n]), flo(At[m]), acc[ai][bj][m][n], 0, 0, 0); \
        acc[ai][bj][m][n] = __builtin_amdgcn_mfma_f32_16x16x32_bf16(fhi(Bt[n]), fhi(At[m]), acc[ai][bj][m][n], 0, 0, 0); } } __builtin_amdgcn_s_setprio(0); } while (0)
#define PG8_WAIT_V(n) asm volatile("s_waitcnt vmcnt(" #n ")" ::: "memory")
#define PG8_WAIT_L(n) asm volatile("s_waitcnt lgkmcnt(" #n ")" ::: "memory")
#define PG8_BAR __builtin_amdgcn_s_barrier()
#define PG8_SCHED __builtin_amdgcn_sched_barrier(0)
    Unit cur, nxt; int ui = 0;
    if (!S.next(0, cur)) return;
    f32x4 acc[2][2][4][2];
#pragma unroll
    for (int a = 0; a < 2; ++a)
#pragma unroll
        for (int b = 0; b < 2; ++b)
#pragma unroll
            for (int m = 0; m < 4; ++m)
#pragma unroll
                for (int n = 0; n < 2; ++n) acc[a][b][m][n] = (f32x4){0.f, 0.f, 0.f, 0.f};
    v8i32 At[4], B0[2], B1[2];
    const char* cA = (const char*)g.A + (GATHER ? (size_t)0 : (size_t)cur.pm * tstep); const char* cB = (const char*)g.Bt + (size_t)cur.pn * tstep;
    S.a_ready(cur);
    if constexpr (GATHER) { const int* rp = rowtok + cur.pm * 256 + (wid >> 1) * 16 + (lane >> 2);
        _Pragma("unroll") for (int q = 0; q < 4; ++q) gA[q] = (unsigned)rp[64 * q] * (unsigned)(K * 2) + gcol; }
    EpiPre<Epi> pre; pre.load(E, cur, wr, wc, lane, lds, wid);
    if constexpr (SP2) {
        PG8_STAGE(PG8_SB(0, 0), cB, voffB); PG8_STAGE(PG8_SB(0, 1), cB + hstep, voffB); PG8_STAGE_A(PG8_SA(0, 0), cA, 0); PG8_STAGE_A(PG8_SA(0, 1), cA, 1);
        if (wr == 1) PG8_BAR;
        PG8_WAIT_V(2); PG8_BAR;
        PG8_STAGE(PG8_SB(1, 0), cB + kstep, voffB); PG8_STAGE_A(PG8_SA(1, 0), cA + kstep, 0); PG8_STAGE(PG8_SB(1, 1), cB + hstep + kstep, voffB);
        PG8_WAIT_V(6); PG8_BAR;
    } else {
        PG8_STAGE(PG8_SB(0, 0), cB, voffB); PG8_STAGE(PG8_SA(0, 0), cA, voffA); PG8_STAGE(PG8_SB(0, 1), cB + hstep, voffB); PG8_STAGE(PG8_SA(0, 1), cA + hstep, voffA);
        if (wr == 1) PG8_BAR;
        PG8_WAIT_V(4); PG8_BAR;
        PG8_STAGE(PG8_SB(1, 0), cB + kstep, voffB); PG8_STAGE(PG8_SA(1, 0), cA + kstep, voffA); PG8_STAGE(PG8_SB(1, 1), cB + hstep + kstep, voffB);
        PG8_WAIT_V(6); PG8_BAR;
    }
    for (;;) {
        const bool has_next = S.next(ui + 1, nxt);
        const char* nA = has_next ? (const char*)g.A + (GATHER ? (size_t)0 : (size_t)nxt.pm * tstep) : cA; const char* nB = has_next ? (const char*)g.Bt + (size_t)nxt.pn * tstep : cB;
#pragma unroll 1
        for (int t = 0; t < nt; t += 2) {
            const bool last = (t == nt - 2);
            const char* a1 = cA + (size_t)(t + 1) * kstep;
            const char* a2 = last ? nA : cA + (size_t)(t + 2) * kstep; const char* b2 = last ? nB : cB + (size_t)(t + 2) * kstep;
            const char* a3 = a2 + kstep; const char* b3 = b2 + kstep;
            if (last && has_next) { S.a_ready(nxt); pre.load_next(E, nxt, wr, wc, lane, lds, wid); }
            if constexpr (GATHER) { if (t == 0 && has_next) dma4((const float*)(rowtok + nxt.pm * 256 + (wid >> 1) * 16 + (lane >> 2) + 64 * (lane & 3)), rts); }
            if constexpr (SP2) {
            PG8_LDB(B0, 0, 0); PG8_LDB(B1, 0, 1); PG8_SCHED; PG8_LDA(At, 0, 0); PG8_STAGE_A(PG8_SA(1, 1), a1, 1);
            if constexpr (GATHER) { if (last && has_next) { asm volatile("" ::: "memory");
                const u32x4 rt = *(const PG8_LAS u32x4*)(rts + 16 * (lane >> 2)); _Pragma("unroll") for (int q = 0; q < 4; ++q) gA[q] = rt[q] * (unsigned)(K * 2) + gcol; } }
            PG8_WAIT_V(8); PG8_WAIT_L(0); PG8_BAR; PG8_MMA(0, 0, At, B0); PG8_MMA(0, 1, At, B1); PG8_BAR; PG8_SCHED;
            PG8_LDA(At, 0, 1); PG8_STAGE(PG8_SB(0, 0), b2, voffB); PG8_STAGE(PG8_SB(0, 1), b2 + hstep, voffB); PG8_STAGE_A(PG8_SA(0, 0), a2, 0);
            PG8_WAIT_V(8); PG8_WAIT_L(0); PG8_BAR; PG8_MMA(1, 0, At, B0); PG8_MMA(1, 1, At, B1); PG8_BAR; PG8_SCHED;
            PG8_LDB(B0, 1, 0); PG8_LDB(B1, 1, 1); PG8_SCHED; PG8_LDA(At, 1, 0); PG8_STAGE_A(PG8_SA(0, 1), a2, 1);
            PG8_WAIT_V(8); PG8_WAIT_L(0); PG8_BAR; PG8_MMA(0, 0, At, B0); PG8_MMA(0, 1, At, B1); PG8_BAR; PG8_SCHED;
            PG8_LDA(At, 1, 1); PG8_STAGE(PG8_SB(1, 0), b3, voffB); PG8_STAGE(PG8_SB(1, 1), b3 + hstep, voffB); PG8_STAGE_A(PG8_SA(1, 0), a3, 0);
            PG8_WAIT_V(8); PG8_WAIT_L(0); PG8_BAR; PG8_MMA(1, 0, At, B0); PG8_MMA(1, 1, At, B1); PG8_BAR; PG8_SCHED;
            } else {
            PG8_LDB(B0, 0, 0); PG8_SCHED; PG8_LDA(At, 0, 0); PG8_STAGE(PG8_SA(1, 1), a1 + hstep, voffA);
            PG8_WAIT_L(8); PG8_BAR; PG8_WAIT_L(0); PG8_MMA(0, 0, At, B0); PG8_BAR; PG8_SCHED;
            PG8_LDB(B1, 0, 1); PG8_STAGE(PG8_SB(0, 0), b2, voffB);
            PG8_BAR; PG8_WAIT_L(0); PG8_MMA(0, 1, At, B1); PG8_BAR;
            PG8_LDA(At, 0, 1); PG8_STAGE(PG8_SA(0, 0), a2, voffA);
            PG8_BAR; PG8_WAIT_L(0); PG8_MMA(1, 0, At, B0); PG8_BAR; PG8_SCHED;
            PG8_STAGE(PG8_SB(0, 1), b2 + hstep, voffB);
            PG8_WAIT_V(6); PG8_BAR; PG8_MMA(1, 1, At, B1); PG8_BAR;
            PG8_LDB(B0, 1, 0); PG8_SCHED; PG8_LDA(At, 1, 0); PG8_STAGE(PG8_SA(0, 1), a2 + hstep, voffA);
            PG8_WAIT_L(8); PG8_BAR; PG8_WAIT_L(0); PG8_MMA(0, 0, At, B0); PG8_BAR; PG8_SCHED;
            PG8_LDB(B1, 1, 1); PG8_STAGE(PG8_SB(1, 0), b3, voffB);
            PG8_BAR; PG8_WAIT_L(0); PG8_MMA(0, 1, At, B1); PG8_BAR;
            PG8_LDA(At, 1, 1); PG8_STAGE(PG8_SA(1, 0), a3, voffA);
            PG8_BAR; PG8_WAIT_L(0); PG8_MMA(1, 0, At, B0); PG8_BAR; PG8_SCHED;
            PG8_STAGE(PG8_SB(1, 1), b3 + hstep, voffB);
            PG8_WAIT_V(6); PG8_BAR; PG8_MMA(1, 1, At, B1); PG8_BAR;
            }
        }
        if constexpr (ALIGN_EPI) { if (wr == 0) PG8_BAR; }
        if constexpr (FP8) { asm volatile("s_nop 15\n\ts_nop 15" ::: "memory"); }
        if constexpr (!Epi::AFTER_DRAIN) { pre.run(E, acc, cur, wr, wc, fr, fq, lds, wid); S.done(cur); }
        if (!has_next) break;
#pragma unroll
        for (int a = 0; a < 2; ++a)
#pragma unroll
            for (int b = 0; b < 2; ++b)
#pragma unroll
                for (int m = 0; m < 4; ++m)
#pragma unroll
                    for (int n = 0; n < 2; ++n) acc[a][b][m][n] = (f32x4){0.f, 0.f, 0.f, 0.f};
        cur = nxt; cA = nA; cB = nB; ++ui;
        if constexpr (ALIGN_EPI) { if (wr == 1) PG8_BAR; }
    }
    PG8_WAIT_V(0);
    if constexpr (!ALIGN_EPI) { if (wr == 0) PG8_BAR; }
    PG8_BAR;
    if constexpr (Epi::AFTER_DRAIN) { E.fused(acc, cur, wr, wc, fr, fq, lds, wid, lane); S.done(cur); }
#undef PG8_SA
#undef PG8_SB
#undef PG8_STAGE
#undef PG8_STAGE_A
#undef PG8_LDA
#undef PG8_LDB
#undef PG8_MMA
#undef PG8_WAIT_V
#undef PG8_WAIT_L
#undef PG8_BAR
#undef PG8_SCHED
}
}

namespace rk {
typedef unsigned short bf16_t;
typedef short bf16x8 __attribute__((ext_vector_type(8)));
typedef float f32x16 __attribute__((ext_vector_type(16)));
typedef float f32x4 __attribute__((ext_vector_type(4)));
typedef unsigned v4u __attribute__((ext_vector_type(4)));
typedef unsigned v2u __attribute__((ext_vector_type(2)));
#define RK_LAS __attribute__((address_space(3)))
constexpr int PB = 72, PF = 65;
constexpr int L_TW = 0, L_DA = 9216, L_F1 = 18432, L_F2 = 35072, L_F3 = 51712, L_BF = 68352, BFB = 9216;
constexpr int L_AP = L_BF, L_RP = L_BF + BFB, L_BM = L_BF + 2 * BFB, L_KM = L_BF + 3 * BFB, L_BHT = L_BF + 4 * BFB, L_KHT = L_BF + 5 * BFB, L_VT = L_BF + 6 * BFB,
              L_LAK = L_BF + 7 * BFB, L_LRB = L_BF + 8 * BFB, L_LRK = L_BF + 9 * BFB, L_END = L_BF + 10 * BFB;
constexpr int L_WT = L_BM, L_U0 = L_KM, L_GT = L_LRK;
constexpr int L_TI = L_F2, L_SCR = L_F2 + 4352;
constexpr int R1_LDS = L_END;
constexpr int P_LD = 3328, C_R = 1536, C_K = 2048, C_V = 2560, C_DW = 3072, C_DA = 3136, C_DG = 3200;
constexpr int UNIT_BYTES = 32768;

typedef float f32x2_t __attribute__((ext_vector_type(2))); typedef __bf16 bf16x2_t __attribute__((ext_vector_type(2)));
__device__ __forceinline__ unsigned cvtpk(float lo, float hi) { f32x2_t v = {lo, hi}; bf16x2_t b = __builtin_convertvector(v, bf16x2_t); return __builtin_bit_cast(unsigned, b); }
__device__ __forceinline__ unsigned short f2b(float f) { return (unsigned short)(cvtpk(f, 0.f) & 0xffffu); }
__device__ __forceinline__ float b2f(unsigned short b) { return __builtin_bit_cast(float, (unsigned)b << 16); }
__device__ __forceinline__ float blo(unsigned u) { return __builtin_bit_cast(float, u << 16); }
__device__ __forceinline__ float bhi(unsigned u) { return __builtin_bit_cast(float, u & 0xffff0000u); }
__device__ __forceinline__ int drow(int q, int hh) { return (q & 3) + 8 * (q >> 2) + 4 * hh; }
__device__ __forceinline__ bf16x8 pack8(const f32x16& d, int s) {
    v4u w; w.x = cvtpk(d[8 * s + 0], d[8 * s + 1]); w.y = cvtpk(d[8 * s + 2], d[8 * s + 3]); w.z = cvtpk(d[8 * s + 4], d[8 * s + 5]); w.w = cvtpk(d[8 * s + 6], d[8 * s + 7]);
    return __builtin_bit_cast(bf16x8, w);
}
__device__ __forceinline__ f32x16 zero16() { f32x16 z;
#pragma unroll
    for (int i = 0; i < 16; ++i) z[i] = 0.f; return z; }
__device__ __forceinline__ bf16x8 ldsfrag(const RK_LAS unsigned char* base, int row, int kofs) { return *(const RK_LAS bf16x8*)(base + (row * PB + kofs) * 2); }
__device__ __forceinline__ void store_dfrag(unsigned char* gbase, int lane, const f32x16& d) {
    v4u w0, w1; w0.x = cvtpk(d[0], d[1]); w0.y = cvtpk(d[2], d[3]); w0.z = cvtpk(d[4], d[5]); w0.w = cvtpk(d[6], d[7]);
    w1.x = cvtpk(d[8], d[9]); w1.y = cvtpk(d[10], d[11]); w1.z = cvtpk(d[12], d[13]); w1.w = cvtpk(d[14], d[15]);
    v4u* p = (v4u*)(gbase + lane * 32); p[0] = w0; p[1] = w1;
}
__device__ __forceinline__ void store_dfrag_nt(unsigned char* gbase, int lane, const f32x16& d) {
    v4u w0, w1; w0.x = cvtpk(d[0], d[1]); w0.y = cvtpk(d[2], d[3]); w0.z = cvtpk(d[4], d[5]); w0.w = cvtpk(d[6], d[7]);
    w1.x = cvtpk(d[8], d[9]); w1.y = cvtpk(d[10], d[11]); w1.z = cvtpk(d[12], d[13]); w1.w = cvtpk(d[14], d[15]);
    v4u* p = (v4u*)(gbase + lane * 32); __builtin_nontemporal_store(w0, p); __builtin_nontemporal_store(w1, p + 1);
}
__device__ __forceinline__ float dppf(float v, const int ctrl_tag) {
    const int b = __builtin_bit_cast(int, v);
    int r;
    if (ctrl_tag == 0) r = __builtin_amdgcn_mov_dpp(b, 0xB1, 0xF, 0xF, true);
    else if (ctrl_tag == 1) r = __builtin_amdgcn_mov_dpp(b, 0x4E, 0xF, 0xF, true);
    else if (ctrl_tag == 2) r = __builtin_amdgcn_mov_dpp(b, 0x141, 0xF, 0xF, true);
    else r = __builtin_amdgcn_mov_dpp(b, 0x140, 0xF, 0xF, true);
    return __builtin_bit_cast(float, r);
}
__device__ __forceinline__ float wsum(float v) {
    v += dppf(v, 0); v += dppf(v, 1); v += dppf(v, 2); v += dppf(v, 3);
    { const unsigned u = __builtin_bit_cast(unsigned, v); auto r = __builtin_amdgcn_permlane16_swap(u, u, false, false); v = __builtin_bit_cast(float, (unsigned)r[0]) + __builtin_bit_cast(float, (unsigned)r[1]); }
    { const unsigned u = __builtin_bit_cast(unsigned, v); auto r = __builtin_amdgcn_permlane32_swap(u, u, false, false); v = __builtin_bit_cast(float, (unsigned)r[0]) + __builtin_bit_cast(float, (unsigned)r[1]); }
    return v;
}
#define RK_SYNC() __syncthreads()


struct R1Args { const bf16_t* P; const float *mu, *w0, *a0, *k_k, *k_a, *r_k; const bf16_t *WdT, *WiT; unsigned char* units; float* gam; float* bon; float* dump; };

__device__ __forceinline__ void r1_block(const R1Args& A, RK_LAS unsigned char* lds, int bc, const int wid_in) {
    const int lane = hw_lane_id(), w = wid_in, tid = w * 64 + lane, r32 = lane & 31, hh = lane >> 5;
    const int b = bc >> 7, c = bc & 127, row0 = b * 8192 + c * 64;
    RK_LAS float* F1 = (RK_LAS float*)(lds + L_F1); RK_LAS float* F2 = (RK_LAS float*)(lds + L_F2); RK_LAS float* F3 = (RK_LAS float*)(lds + L_F3);
    struct HeadIn { bf16_t r[8], k[8], v[8], pr, pk, pv; float w0c, a0c, kkc, kac, rkc, mur, muk, muv; bf16x8 bf[4]; };
    auto load_head = [&](HeadIn& H, int h) {
        const int ch = h * 64 + lane;
        const bf16_t* prow = A.P + (size_t)(row0 + 8 * w) * P_LD + ch;
#pragma unroll
        for (int u = 0; u < 8; ++u) { H.r[u] = prow[(size_t)u * P_LD + C_R]; H.k[u] = prow[(size_t)u * P_LD + C_K]; H.v[u] = prow[(size_t)u * P_LD + C_V]; }
        H.pr = 0; H.pk = 0; H.pv = 0;
        if (w > 0 || c > 0) { H.pr = prow[C_R - P_LD]; H.pk = prow[C_K - P_LD]; H.pv = prow[C_V - P_LD]; }
        H.w0c = A.w0[ch]; H.a0c = A.a0[ch]; H.kkc = A.k_k[ch]; H.kac = A.k_a[ch]; H.rkc = A.r_k[ch];
        H.mur = A.mu[ch]; H.muk = A.mu[512 + ch]; H.muv = A.mu[1024 + ch];
        const int m = w >> 2, cb = w & 1;
        const bf16_t* Wt = (m ? A.WiT : A.WdT) + (size_t)(h * 64 + 32 * cb + r32) * 64 + 8 * hh;
#pragma unroll
        for (int s = 0; s < 4; ++s) H.bf[s] = *(const bf16x8*)(Wt + 16 * s);
    };
    HeadIn Hn; load_head(Hn, 0);
    {
        const int t = tid >> 3, cg = tid & 7, col = (cg & 3) * 16;
        const bf16_t* pc = A.P + (size_t)(row0 + t) * P_LD + C_DW + cg * 16;
        const bool hp = (t > 0 || c > 0); const int pofs = hp ? -P_LD : 0; const v4u zero4 = {0, 0, 0, 0};
        v4u c0 = *(const v4u*)pc, c1 = *(const v4u*)(pc + 8), p0 = *(const v4u*)(pc + pofs), p1 = *(const v4u*)(pc + pofs + 8);
        p0 = hp ? p0 : zero4; p1 = hp ? p1 : zero4;
        const unsigned cu[8] = {c0.x, c0.y, c0.z, c0.w, c1.x, c1.y, c1.z, c1.w}, pu[8] = {p0.x, p0.y, p0.z, p0.w, p1.x, p1.y, p1.z, p1.w};
        const float* mup = A.mu + (C_DW - C_R) + cg * 16;
        unsigned o[8];
#pragma unroll
        for (int i = 0; i < 8; ++i) {
            float x0 = blo(cu[i]), x1 = bhi(cu[i]); const float q0 = blo(pu[i]), q1 = bhi(pu[i]);
            x0 = x0 + (q0 - x0) * mup[2 * i]; x1 = x1 + (q1 - x1) * mup[2 * i + 1];
            if (cg < 4) { x0 = 1.f - 2.f * __builtin_amdgcn_rcpf(1.f + __expf(2.f * x0)); x1 = 1.f - 2.f * __builtin_amdgcn_rcpf(1.f + __expf(2.f * x1)); }
            o[i] = cvtpk(x0, x1);
        }
        RK_LAS v4u* dst = (RK_LAS v4u*)(lds + (cg < 4 ? L_TW : L_DA) + (t * PB + col) * 2);
        dst[0] = (v4u){o[0], o[1], o[2], o[3]}; dst[1] = (v4u){o[4], o[5], o[6], o[7]};
    }
    RK_SYNC();
    for (int h = 0; h < 8; ++h) {
        const int unit = (b * 8 + h) * 128 + c;
        unsigned char* ub = A.units + (size_t)unit * UNIT_BYTES;
        const HeadIn Hc = Hn;
        load_head(Hn, h < 7 ? h + 1 : 7);
        const bf16_t* g_r = Hc.r; const bf16_t* g_k = Hc.k; const bf16_t* g_v = Hc.v; const bf16_t g_pr = Hc.pr, g_pk = Hc.pk, g_pv = Hc.pv;
        const float w0c = Hc.w0c, a0c = Hc.a0c, kkc = Hc.kkc, kac = Hc.kac, rkc = Hc.rkc, mur = Hc.mur, muk = Hc.muk, muv = Hc.muv;
        float gamma_l = 1.f;
        {
            const int m = w >> 2, tb = (w >> 1) & 1, cb = w & 1;
            const RK_LAS unsigned char* Ab = lds + (m ? L_DA : L_TW);
            f32x16 acc = zero16(); (void)cb;
#pragma unroll
            for (int s = 0; s < 4; ++s) {
                const bf16x8 af = ldsfrag(Ab, 32 * tb + r32, 16 * s + 8 * hh);
                acc = __builtin_amdgcn_mfma_f32_32x32x16_bf16(af, Hc.bf[s], acc, 0, 0, 0);
            }
            RK_LAS float* F = m ? F2 : F1;
#pragma unroll
            for (int q = 0; q < 16; ++q) F[(32 * tb + drow(q, hh)) * PF + 32 * cb + r32] = acc[q];
        }
        RK_SYNC();
        {
            float lw[8], loc[8]; float run = 0.f;
#pragma unroll
            for (int u = 0; u < 8; ++u) {
                const float z = -(F1[(8 * w + u) * PF + lane] + w0c);
                const float sp = fmaxf(z, 0.f) + __logf(1.f + __expf(-fabsf(z)));
                lw[u] = -__expf(-sp - 0.5f); run += lw[u]; loc[u] = run;
            }
            RK_LAS float* GT = (RK_LAS float*)(lds + L_GT);
            GT[w * 64 + lane] = run;
            RK_SYNC();
            float off = 0.f, cumC = 0.f;
#pragma unroll
            for (int g = 0; g < 8; ++g) { const float v = GT[g * 64 + lane]; cumC += v; if (g < w) off += v; }
            gamma_l = __expf(cumC);
            if (w == 0) A.gam[(size_t)unit * 64 + lane] = gamma_l;
            float pr = b2f(g_pr), pk = b2f(g_pk), pv = b2f(g_pv);
            float eprev_c = __expf(off);
            float tb_[8], tk_[8], tv_[8];
            RK_LAS bf16_t* AP = (RK_LAS bf16_t*)(lds + L_AP); RK_LAS bf16_t* RP = (RK_LAS bf16_t*)(lds + L_RP); RK_LAS bf16_t* BM = (RK_LAS bf16_t*)(lds + L_BM); RK_LAS bf16_t* KM = (RK_LAS bf16_t*)(lds + L_KM);
            RK_LAS bf16_t* BHT = (RK_LAS bf16_t*)(lds + L_BHT); RK_LAS bf16_t* KHT = (RK_LAS bf16_t*)(lds + L_KHT); RK_LAS bf16_t* VT = (RK_LAS bf16_t*)(lds + L_VT);
#pragma unroll
            for (int u = 0; u < 8; ++u) {
                const int t = 8 * w + u;
                const float cr = b2f(g_r[u]), ck = b2f(g_k[u]), cv = b2f(g_v[u]);
                const float rr = cr + (pr - cr) * mur, kx = ck + (pk - ck) * muk, vx = cv + (pv - cv) * muv;
                pr = cr; pk = ck; pv = cv;
                const float iclr = __builtin_amdgcn_rcpf(1.f + __expf(-(F2[t * PF + lane] + a0c)));
                const float kkv = kx * kkc; const float kn = kkv * rsqrtf(fmaxf(wsum(kkv * kkv), 1e-24f));
                const float kt = kx * (1.f + (iclr - 1.f) * kac), av = -kn, bv = kn * iclr;
                const float bsum = wsum(rr * kt * rkc);
                if (lane == 0) A.bon[(size_t)(row0 + t) * 8 + h] = bsum;
                const float cum = off + loc[u];
                const float ecum = __expf(cum), einv = __builtin_amdgcn_rcpf(ecum), ehat = gamma_l * einv;
                const float eprev = eprev_c; eprev_c = ecum;
                AP[t * PB + lane] = f2b(av * eprev); RP[t * PB + lane] = f2b(rr * ecum); BM[t * PB + lane] = f2b(bv * einv); KM[t * PB + lane] = f2b(kt * einv);
                tb_[u] = bv * ehat; tk_[u] = kt * ehat; tv_[u] = vx;
            }
            *(RK_LAS v4u*)(BHT + lane * PB + 8 * w) = (v4u){cvtpk(tb_[0], tb_[1]), cvtpk(tb_[2], tb_[3]), cvtpk(tb_[4], tb_[5]), cvtpk(tb_[6], tb_[7])};
            *(RK_LAS v4u*)(KHT + lane * PB + 8 * w) = (v4u){cvtpk(tk_[0], tk_[1]), cvtpk(tk_[2], tk_[3]), cvtpk(tk_[4], tk_[5]), cvtpk(tk_[6], tk_[7])};
            *(RK_LAS v4u*)(VT + lane * PB + 8 * w) = (v4u){cvtpk(tv_[0], tv_[1]), cvtpk(tv_[2], tv_[3]), cvtpk(tv_[4], tv_[5]), cvtpk(tv_[6], tv_[7])};
        }
        RK_SYNC();
        {
            const int m = w >> 1, tb = w & 1;
            const RK_LAS unsigned char* Ab = lds + ((m < 2) ? L_AP : L_RP);
            const RK_LAS unsigned char* Bb = lds + ((m & 1) ? L_KM : L_BM);
            const bool incl = m >= 2;
#pragma unroll
            for (int jb = 0; jb < 2; ++jb) {
                f32x16 acc = zero16();
                if (jb <= tb) {
#pragma unroll
                    for (int s = 0; s < 4; ++s) acc = __builtin_amdgcn_mfma_f32_32x32x16_bf16(ldsfrag(Ab, 32 * tb + r32, 16 * s + 8 * hh), ldsfrag(Bb, 32 * jb + r32, 16 * s + 8 * hh), acc, 0, 0, 0);
                }
                const int j = 32 * jb + r32;
#pragma unroll
                for (int q = 0; q < 16; ++q) {
                    const int t = 32 * tb + drow(q, hh);
                    const float v = (j < t || (incl && j == t)) ? acc[q] : 0.f;
                    if (m == 0) F3[t * PF + j] = v;
                    else ((RK_LAS bf16_t*)(lds + (m == 1 ? L_LAK : (m == 2 ? L_LRB : L_LRK))))[t * PB + j] = f2b(v);
                }
            }
        }
        RK_SYNC();
        if (w < 4) {
            const int ib = w >> 1, tb = w & 1;
            f32x16 acc = zero16();
#pragma unroll
            for (int s = 0; s < 4; ++s) acc = __builtin_amdgcn_mfma_f32_32x32x16_bf16(ldsfrag(lds + L_VT, 32 * ib + r32, 16 * s + 8 * hh), ldsfrag(lds + L_LAK, 32 * tb + r32, 16 * s + 8 * hh), acc, 0, 0, 0);
#pragma unroll
            for (int q = 0; q < 16; ++q) F1[(32 * ib + drow(q, hh)) * PF + 32 * tb + r32] = acc[q];
        } else {
            const int qb = w - 4, l15 = lane & 15, g = lane >> 4;
            RK_LAS float* X = (RK_LAS float*)(lds + L_SCR) + (w - 4) * 2 * 272;
            RK_LAS float* Y = X + 272;
            RK_LAS float* TI = (RK_LAS float*)(lds + L_TI) + qb * 272;
#pragma unroll
            for (int e = 0; e < 4; ++e) { const int rr = 4 * g + e; const float v = F3[(16 * qb + rr) * PF + 16 * qb + l15]; X[rr * 17 + l15] = v; TI[rr * 17 + l15] = v + (rr == l15 ? 1.f : 0.f); }
            asm volatile("s_waitcnt lgkmcnt(0)" ::: "memory");
#pragma unroll
            for (int it = 0; it < 3; ++it) {
                f32x4 acc = {0.f, 0.f, 0.f, 0.f};
#pragma unroll
                for (int s = 0; s < 4; ++s) acc = __builtin_amdgcn_mfma_f32_16x16x4f32(X[l15 * 17 + 4 * s + g], X[(4 * s + g) * 17 + l15], acc, 0, 0, 0);
#pragma unroll
                for (int e = 0; e < 4; ++e) Y[(4 * g + e) * 17 + l15] = acc[e];
                asm volatile("s_waitcnt lgkmcnt(0)" ::: "memory");
                f32x4 acc2;
#pragma unroll
                for (int e = 0; e < 4; ++e) acc2[e] = TI[(4 * g + e) * 17 + l15];
#pragma unroll
                for (int s = 0; s < 4; ++s) acc2 = __builtin_amdgcn_mfma_f32_16x16x4f32(TI[l15 * 17 + 4 * s + g], Y[(4 * s + g) * 17 + l15], acc2, 0, 0, 0);
                asm volatile("s_waitcnt lgkmcnt(0)" ::: "memory");
#pragma unroll
                for (int e = 0; e < 4; ++e) TI[(4 * g + e) * 17 + l15] = acc2[e];
                RK_LAS float* tsw = X; X = Y; Y = tsw;
                asm volatile("s_waitcnt lgkmcnt(0)" ::: "memory");
            }
        }
        RK_SYNC();
        {
            const int l15 = lane & 15, g = lane >> 4;
            RK_LAS float* SC = (RK_LAS float*)(lds + L_SCR) + w * 272;
            const RK_LAS float* TIb = (const RK_LAS float*)(lds + L_TI);
            float xa[3][4];
#pragma unroll
            for (int i = 0; i < 4; ++i) {
                f32x4 acc;
                if (w < 4) { const v2u u2 = *(const RK_LAS v2u*)(lds + L_AP + ((16 * i + l15) * PB + 16 * w + 4 * g) * 2); acc = (f32x4){blo(u2.x), bhi(u2.x), blo(u2.y), bhi(u2.y)}; }
                else {
#pragma unroll
                    for (int e = 0; e < 4; ++e) acc[e] = F1[(16 * (w - 4) + 4 * g + e) * PF + 16 * i + l15];
                }
#pragma unroll
                for (int j = 0; j < 3; ++j) if (j < i) {
#pragma unroll
                    for (int s = 0; s < 4; ++s) acc = __builtin_amdgcn_mfma_f32_16x16x4f32(xa[j][s], F3[(16 * i + l15) * PF + 16 * j + 4 * s + g], acc, 0, 0, 0);
                }
#pragma unroll
                for (int e = 0; e < 4; ++e) SC[(4 * g + e) * 17 + l15] = acc[e];
                asm volatile("s_waitcnt lgkmcnt(0)" ::: "memory");
                f32x4 xi = {0.f, 0.f, 0.f, 0.f};
#pragma unroll
                for (int s = 0; s < 4; ++s) xi = __builtin_amdgcn_mfma_f32_16x16x4f32(SC[l15 * 17 + 4 * s + g], TIb[i * 272 + l15 * 17 + 4 * s + g], xi, 0, 0, 0);
                asm volatile("s_waitcnt lgkmcnt(0)" ::: "memory");
                RK_LAS bf16_t* O = (RK_LAS bf16_t*)(lds + (w < 4 ? L_WT : L_U0));
#pragma unroll
                for (int e = 0; e < 4; ++e) O[(16 * (w & 3) + 4 * g + e) * PB + 16 * i + l15] = f2b(xi[e]);
                if (i < 3) {
#pragma unroll
                    for (int e = 0; e < 4; ++e) SC[(4 * g + e) * 17 + l15] = xi[e];
                    asm volatile("s_waitcnt lgkmcnt(0)" ::: "memory");
#pragma unroll
                    for (int s = 0; s < 4; ++s) xa[i][s] = SC[l15 * 17 + 4 * s + g];
                    asm volatile("s_waitcnt lgkmcnt(0)" ::: "memory");
                }
            }
        }
        RK_SYNC();
        {
            const int m = w >> 1, x = w & 1;
#pragma unroll
            for (int y = 0; y < 2; ++y) {
                f32x16 acc = zero16();
                if (m == 2) {
#pragma unroll
                    for (int qq = 0; qq < 4; ++qq) { const v2u u2 = *(const RK_LAS v2u*)(lds + L_RP + ((32 * y + r32) * PB + 32 * x + 8 * qq + 4 * hh) * 2);
                        acc[4 * qq + 0] = blo(u2.x); acc[4 * qq + 1] = bhi(u2.x); acc[4 * qq + 2] = blo(u2.y); acc[4 * qq + 3] = bhi(u2.y); }
                }
                const int A1 = (m == 0 || m == 2) ? L_WT : (m == 1 ? L_BHT : L_U0);
                const int B1 = (m == 0) ? L_BHT : (m == 1 ? L_U0 : L_LRB);
#pragma unroll
                for (int s = 0; s < 4; ++s) acc = __builtin_amdgcn_mfma_f32_32x32x16_bf16(ldsfrag(lds + A1, 32 * x + r32, 16 * s + 8 * hh), ldsfrag(lds + B1, 32 * y + r32, 16 * s + 8 * hh), acc, 0, 0, 0);
                if (m == 1 || m == 3) {
                    const int A2 = (m == 1) ? L_KHT : L_VT, B2 = (m == 1) ? L_VT : L_LRK;
#pragma unroll
                    for (int s = 0; s < 4; ++s) acc = __builtin_amdgcn_mfma_f32_32x32x16_bf16(ldsfrag(lds + A2, 32 * x + r32, 16 * s + 8 * hh), ldsfrag(lds + B2, 32 * y + r32, 16 * s + 8 * hh), acc, 0, 0, 0);
                }
                if (m == 0 && x == y) {
                    const float go = __shfl_xor(gamma_l, 32); const float gn = (hh == y) ? gamma_l : go;
#pragma unroll
                    for (int q = 0; q < 16; ++q) if (drow(q, hh) == r32) acc[q] -= (1.f - gn);
                }
                if (m >= 2) store_dfrag_nt(ub + m * 8192 + (x * 2 + y) * 2048, lane, acc); else store_dfrag(ub + m * 8192 + (x * 2 + y) * 2048, lane, acc);
            }
        }
        RK_SYNC();
    }
}

struct R2Args { const unsigned char* units; const float* gam; unsigned char* zs; };
constexpr int R2_SLOT = 16384, R2_NS = 8, R2_X = R2_NS * R2_SLOT;
__device__ __forceinline__ void r2_block(const R2Args& A, RK_LAS unsigned char* lds, int bh, const int wid_in) {
    const int lane = hw_lane_id(), w = wid_in;
    if (w >= 4) {
        const int lw = w - 4;
        v4u buf[8][4];
        const unsigned char* ubase = A.units + (size_t)bh * 128 * UNIT_BYTES + lw * 1024 + lane * 16;
        const int d0 = lw * 1024 + lane * 16;
#pragma unroll
        for (int c = 0; c < 7; ++c) {
            v4u a[4];
#pragma unroll
            for (int k = 0; k < 4; ++k) a[k] = *(const v4u*)(ubase + (size_t)c * UNIT_BYTES + k * 4096);
#pragma unroll
            for (int k = 0; k < 4; ++k) *(RK_LAS v4u*)(lds + c * R2_SLOT + d0 + k * 4096) = a[k];
        }
#pragma unroll
        for (int c = 7; c < 15; ++c)
#pragma unroll
            for (int k = 0; k < 4; ++k) buf[c & 7][k] = *(const v4u*)(ubase + (size_t)c * UNIT_BYTES + k * 4096);
        __syncthreads();
        __syncthreads();
        for (int c0 = 0; c0 < 128; c0 += 8) {
#pragma unroll
            for (int u = 0; u < 8; ++u) {
                const int c = c0 + u;
                RK_LAS unsigned char* slot = lds + ((u + 7) & 7) * R2_SLOT + d0;
#pragma unroll
                for (int k = 0; k < 4; ++k) *(RK_LAS v4u*)(slot + k * 4096) = buf[(u + 7) & 7][k];
                const int cn = (c + 15 < 128) ? c + 15 : 127;
#pragma unroll
                for (int k = 0; k < 4; ++k) buf[(u + 7) & 7][k] = *(const v4u*)(ubase + (size_t)cn * UNIT_BYTES + k * 4096);
                __syncthreads();
            }
        }
    } else {
        const int rt = w >> 1, cb = w & 1, pw = w ^ 2;
        f32x16 Z = zero16();
        bf16x8 zo[2];
        { const v4u z4 = {0u, 0u, 0u, 0u}; zo[0] = __builtin_bit_cast(bf16x8, z4); zo[1] = zo[0];
          *(RK_LAS bf16x8*)(lds + R2_X + (0 * 4 + w) * 2048 + lane * 32) = zo[0]; *(RK_LAS bf16x8*)(lds + R2_X + (0 * 4 + w) * 2048 + lane * 32 + 16) = zo[0]; }
        bf16x8 pa[2][2], pb[2][2]; v4u qa[2], qb[2];
        __syncthreads();
#define R2_READ(P_, Q_, SLOT_) do { _Pragma("unroll") for (int kb = 0; kb < 2; ++kb) { const RK_LAS bf16x8* pp = (const RK_LAS bf16x8*)((SLOT_) + (kb * 2 + rt) * 2048 + lane * 32); P_[kb][0] = pp[0]; P_[kb][1] = pp[1]; } \
        { const RK_LAS v4u* qp = (const RK_LAS v4u*)((SLOT_) + 8192 + (rt * 2 + cb) * 2048 + lane * 32); Q_[0] = qp[0]; Q_[1] = qp[1]; } } while (0)
#define R2_STEP(P_, Q_, C_) do { \
        const RK_LAS bf16x8* xp = (const RK_LAS bf16x8*)(lds + R2_X + (((C_) & 1) * 4 + pw) * 2048 + lane * 32); const bf16x8 zp0 = xp[0], zp1 = xp[1]; \
        { v4u* zg = (v4u*)(zb + (size_t)(C_) * 8192 + (rt * 2 + cb) * 2048 + lane * 32); zg[0] = __builtin_bit_cast(v4u, zo[0]); zg[1] = __builtin_bit_cast(v4u, zo[1]); } \
        const unsigned qu[8] = {Q_[0].x, Q_[0].y, Q_[0].z, Q_[0].w, Q_[1].x, Q_[1].y, Q_[1].z, Q_[1].w}; \
        f32x16 acc, acc1 = zero16(); _Pragma("unroll") for (int q = 0; q < 16; ++q) acc[q] = Z[q] + ((q & 1) ? bhi(qu[q >> 1]) : blo(qu[q >> 1])); \
          \
        acc  = __builtin_amdgcn_mfma_f32_32x32x16_bf16(P_[0][0], (0 == rt) ? zo[0] : zp0, acc, 0, 0, 0); \
        acc1 = __builtin_amdgcn_mfma_f32_32x32x16_bf16(P_[1][0], (1 == rt) ? zo[0] : zp0, acc1, 0, 0, 0); \
        acc  = __builtin_amdgcn_mfma_f32_32x32x16_bf16(P_[0][1], (0 == rt) ? zo[1] : zp1, acc, 0, 0, 0); \
        acc1 = __builtin_amdgcn_mfma_f32_32x32x16_bf16(P_[1][1], (1 == rt) ? zo[1] : zp1, acc1, 0, 0, 0); \
        _Pragma("unroll") for (int q = 0; q < 16; ++q) Z[q] = acc[q] + acc1[q]; \
        zo[0] = pack8(Z, 0); zo[1] = pack8(Z, 1); \
        { RK_LAS bf16x8* xo = (RK_LAS bf16x8*)(lds + R2_X + ((((C_) + 1) & 1) * 4 + w) * 2048 + lane * 32); xo[0] = zo[0]; xo[1] = zo[1]; } } while (0)
        R2_READ(pa, qa, lds);
        asm volatile("s_waitcnt lgkmcnt(0)" ::: "memory");
        __syncthreads();
        unsigned char* zb = A.zs + (size_t)(bh * 128) * 8192;
        for (int c = 0; c < 128; c += 2) {
            R2_READ(pb, qb, lds + ((c + 1) & 7) * R2_SLOT);
            R2_STEP(pa, qa, c);
            __syncthreads();
            R2_READ(pa, qa, lds + ((c + 2) & 7) * R2_SLOT);
            R2_STEP(pb, qb, c + 1);
            __syncthreads();
        }
#undef R2_READ
#undef R2_STEP
    }
}

struct R3Args { const bf16_t* P; const float *mu, *lnw, *lnb; const bf16_t* WgT; const unsigned char* units; const unsigned char* zs; const float* bon; bf16_t* ymix; float* ypre; float* gdbg; };
constexpr int R3_SG = 0, R3_PITCH = 136, R3_V = 64 * 136 * 2, R3_VP = 520, R3_LN = R3_V + 64 * R3_VP * 2, R3_LDS = R3_LN + 4096;
__device__ __forceinline__ void r3_block(const R3Args& A, RK_LAS unsigned char* lds, int bc, const int wid_in) {
    const int lane = hw_lane_id(), h = wid_in, tid = h * 64 + lane, r32 = lane & 31, hh = lane >> 5;
    const int b = bc >> 7, c = bc & 127, row0 = b * 8192 + c * 64;
    const int unit = (b * 8 + h) * 128 + c;
    const unsigned char* ub = A.units + (size_t)unit * UNIT_BYTES;
    const unsigned char* zb = A.zs + (size_t)unit * 8192;
    bf16x8 zf[2][2][2], gf[2][2][2];
    float bon2[2];
    if (tid < 256) { const f32x4 v = *(const f32x4*)((tid < 128 ? A.lnw : A.lnb) + 4 * (tid & 127)); *(RK_LAS f32x4*)(lds + R3_LN + tid * 16) = v; }
    {
        const int t = tid >> 3, cg = tid & 7;
        const bf16_t* pc = A.P + (size_t)(row0 + t) * P_LD + C_DG + cg * 16;
        const bool hp = (t > 0 || c > 0); const int pofs = hp ? -P_LD : 0;
        const v4u zero4 = {0, 0, 0, 0};
        const bf16_t* pvr = A.P + (size_t)(row0 + t) * P_LD + C_V + cg * 64;
        v4u vc[8], vp[8];
#pragma unroll
        for (int k = 0; k < 8; ++k) { vc[k] = *(const v4u*)(pvr + 8 * k); vp[k] = *(const v4u*)(pvr + pofs + 8 * k); }
        v4u c0 = *(const v4u*)pc, c1 = *(const v4u*)(pc + 8), p0 = *(const v4u*)(pc + pofs), p1 = *(const v4u*)(pc + pofs + 8);
        asm volatile("" ::: "memory");
#pragma unroll
        for (int kb = 0; kb < 2; ++kb)
#pragma unroll
            for (int x = 0; x < 2; ++x) {
                const bf16x8* zp = (const bf16x8*)(zb + (kb * 2 + x) * 2048 + lane * 32); zf[kb][x][0] = __builtin_nontemporal_load(zp); zf[kb][x][1] = __builtin_nontemporal_load(zp + 1);
                const bf16x8* gp = (const bf16x8*)(ub + 2 * 8192 + (kb * 2 + x) * 2048 + lane * 32); gf[kb][x][0] = __builtin_nontemporal_load(gp); gf[kb][x][1] = __builtin_nontemporal_load(gp + 1);
            }
        bon2[0] = A.bon[(size_t)(row0 + r32) * 8 + h]; bon2[1] = A.bon[(size_t)(row0 + 32 + r32) * 8 + h];
        asm volatile("" ::: "memory");
        p0 = hp ? p0 : zero4; p1 = hp ? p1 : zero4;
        const unsigned cu[8] = {c0.x, c0.y, c0.z, c0.w, c1.x, c1.y, c1.z, c1.w}, pu[8] = {p0.x, p0.y, p0.z, p0.w, p1.x, p1.y, p1.z, p1.w};
        const float* mup = A.mu + (C_DG - C_R) + cg * 16;
        unsigned o[8];
#pragma unroll
        for (int i = 0; i < 8; ++i) {
            float x0 = blo(cu[i]), x1 = bhi(cu[i]); const float q0 = blo(pu[i]), q1 = bhi(pu[i]);
            x0 = x0 + (q0 - x0) * mup[2 * i]; x1 = x1 + (q1 - x1) * mup[2 * i + 1];
            o[i] = cvtpk(__builtin_amdgcn_rcpf(1.f + __expf(-x0)), __builtin_amdgcn_rcpf(1.f + __expf(-x1)));
        }
        RK_LAS v4u* dst = (RK_LAS v4u*)(lds + R3_SG + (t * R3_PITCH + cg * 16) * 2);
        dst[0] = (v4u){o[0], o[1], o[2], o[3]}; dst[1] = (v4u){o[4], o[5], o[6], o[7]};
        const float* muv = A.mu + 1024 + cg * 64;
#pragma unroll
        for (int k = 0; k < 8; ++k) {
            const v4u cv = vc[k]; const v4u pv4 = hp ? vp[k] : zero4;
            const unsigned cw[4] = {cv.x, cv.y, cv.z, cv.w}, pw[4] = {pv4.x, pv4.y, pv4.z, pv4.w};
            unsigned ov[4];
#pragma unroll
            for (int i = 0; i < 4; ++i) { const float a0 = blo(cw[i]), a1 = bhi(cw[i]); ov[i] = cvtpk(a0 + (blo(pw[i]) - a0) * muv[8 * k + 2 * i], a1 + (bhi(pw[i]) - a1) * muv[8 * k + 2 * i + 1]); }
            *(RK_LAS v4u*)(lds + R3_V + (t * R3_VP + cg * 64 + 8 * k) * 2) = (v4u){ov[0], ov[1], ov[2], ov[3]};
        }
    }
    RK_SYNC();
#pragma unroll
    for (int tb = 0; tb < 2; ++tb) {
        asm volatile("" ::: "memory");
        f32x16 y[2];
#pragma unroll
        for (int ib = 0; ib < 2; ++ib) {
            const v4u* yp = (const v4u*)(ub + 3 * 8192 + (ib * 2 + tb) * 2048 + lane * 32);
            const v4u q0 = __builtin_nontemporal_load(yp), q1 = __builtin_nontemporal_load(yp + 1);
            const unsigned qu[8] = {q0.x, q0.y, q0.z, q0.w, q1.x, q1.y, q1.z, q1.w};
            f32x16 acc;
#pragma unroll
            for (int q = 0; q < 16; ++q) acc[q] = (q & 1) ? bhi(qu[q >> 1]) : blo(qu[q >> 1]);
#pragma unroll
            for (int kb = 0; kb < 2; ++kb)
#pragma unroll
                for (int s = 0; s < 2; ++s) acc = __builtin_amdgcn_mfma_f32_32x32x16_bf16(zf[kb][ib][s], gf[kb][tb][s], acc, 0, 0, 0);
            y[ib] = acc;
        }
        f32x16 gt[2];
#pragma unroll
        for (int ib = 0; ib < 2; ++ib) {
            f32x16 acc = zero16();
            const bf16_t* wg = A.WgT + (size_t)(h * 64 + 32 * ib + r32) * 128 + 8 * hh;
#pragma unroll
            for (int s = 0; s < 8; ++s) acc = __builtin_amdgcn_mfma_f32_32x32x16_bf16(*(const bf16x8*)(wg + 16 * s), *(const RK_LAS bf16x8*)(lds + R3_SG + ((32 * tb + r32) * R3_PITCH + 16 * s + 8 * hh) * 2), acc, 0, 0, 0);
            gt[ib] = acc;
        }
        if (A.ypre) {
#pragma unroll
            for (int ib = 0; ib < 2; ++ib)
#pragma unroll
                for (int q = 0; q < 16; ++q) { const size_t o = (size_t)(row0 + 32 * tb + r32) * 512 + h * 64 + 32 * ib + drow(q, hh); A.ypre[o] = y[ib][q]; A.gdbg[o] = gt[ib][q]; }
        }
        float s1 = 0.f;
#pragma unroll
        for (int ib = 0; ib < 2; ++ib)
#pragma unroll
            for (int q = 0; q < 16; ++q) s1 += y[ib][q];
        s1 += __shfl_xor(s1, 32);
        const float mean = s1 * (1.f / 64.f);
        float s2 = 0.f;
#pragma unroll
        for (int ib = 0; ib < 2; ++ib)
#pragma unroll
            for (int q = 0; q < 16; ++q) { const float d = y[ib][q] - mean; s2 += d * d; }
        s2 += __shfl_xor(s2, 32);
        const float rstd = rsqrtf(s2 * (1.f / 64.f) + 64e-5f);
        const int t = 32 * tb + r32, row = row0 + t;
        const float bon = bon2[tb]; (void)row;
        RK_LAS unsigned char* vrow = lds + R3_V + (t * R3_VP + h * 64) * 2;
#pragma unroll
        for (int ib = 0; ib < 2; ++ib)
#pragma unroll
            for (int qq = 0; qq < 4; ++qq) {
                asm volatile("" ::: "memory");
                const int i0 = 32 * ib + 8 * qq + 4 * hh;
                const v2u cu = *(const RK_LAS v2u*)(vrow + i0 * 2);
                const float vxx[4] = {blo(cu.x), bhi(cu.x), blo(cu.y), bhi(cu.y)};
                const f32x4 lw4 = *(const RK_LAS f32x4*)(lds + R3_LN + (h * 64 + i0) * 4), lb4 = *(const RK_LAS f32x4*)(lds + R3_LN + 2048 + (h * 64 + i0) * 4);
                float o[4];
#pragma unroll
                for (int e = 0; e < 4; ++e) {
                    const float yn = (y[ib][4 * qq + e] - mean) * rstd * lw4[e] + lb4[e] + bon * vxx[e];
                    o[e] = yn * gt[ib][4 * qq + e];
                }
                *(RK_LAS v2u*)(vrow + i0 * 2) = (v2u){cvtpk(o[0], o[1]), cvtpk(o[2], o[3])};
            }
    }
    asm volatile("s_waitcnt lgkmcnt(0)" ::: "memory");
#pragma unroll
    for (int it = 0; it < 8; ++it) {
        const int t = it * 8 + (lane >> 3), ck = lane & 7;
        const v4u w4 = *(const RK_LAS v4u*)(lds + R3_V + (t * R3_VP + h * 64 + ck * 8) * 2);
        *(v4u*)(A.ymix + (size_t)(row0 + t) * 1024 + 512 + h * 64 + ck * 8) = w4;
    }
}
}
#ifndef REP_P0
#define REP_P0 1
#endif
#ifndef REP_G1
#define REP_G1 1
#endif
#ifndef REP_P3
#define REP_P3 1
#endif
#ifndef REP_P10
#define REP_P10 1
#endif
#ifndef REP_P6
#define REP_P6 1
#endif
#ifndef REP_R2
#define REP_R2 1
#endif
#ifndef P3_ITEMS
#define P3_ITEMS (240 * 8 * 16)
#endif
#ifndef TAIL_GU
#define TAIL_GU (192 * 8 * 3)
#endif
#ifndef TAIL_ITEMS
#define TAIL_ITEMS (192 * 8 * 6)
#endif
#ifndef REP_MOE
#define REP_MOE 1
#endif
namespace {
using pg8::bf16_t;
#define LAS __attribute__((address_space(3)))
#define GAS __attribute__((address_space(1)))
typedef unsigned v4u __attribute__((ext_vector_type(4)));
typedef float f32x4 __attribute__((ext_vector_type(4)));
constexpr int B_ = 2, S_ = 8192, D_ = 1024, T_ = B_ * S_;
constexpr int CW = 512, RW = 512, H_ = 8, N_ = 64;
constexpr int RC = 3 * RW + 64 + 64 + 128;
constexpr int INC = 3 * CW + RC;
constexpr int E_ = 32, TOPK = 4, FF = 1024;
constexpr int NP = T_ * TOPK;
constexpr int ROWS_PAD = NP + E_ * 256;
constexpr int NWAVES = 8, NTHR = 512, GRID = 256;
constexpr int MISC_OFF = 160512;
constexpr int LDS_BYTES = MISC_OFF + 256;
constexpr size_t MiB = 1u << 20;
constexpr size_t WS_CTL = 0;
constexpr size_t WS_WIN = 1 * MiB;
constexpr size_t WS_WOUT = 8 * MiB;
constexpr size_t WS_SMALL = 10 * MiB;
constexpr size_t WS_W2 = 14 * MiB;
constexpr size_t WS_LORA = 15 * MiB;
constexpr size_t WS_WGU = 16 * MiB;
constexpr size_t WS_WDN = 144 * MiB;
constexpr size_t WS_XN = 208 * MiB;
constexpr size_t WS_H1 = 240 * MiB;
constexpr size_t WS_YMIX = 304 * MiB;
constexpr size_t WS_P = 368 * MiB;
constexpr size_t WS_UNITS = 472 * MiB;
constexpr size_t WS_ZS = 536 * MiB;
constexpr size_t WS_GAM = 552 * MiB;
constexpr size_t WS_BON = 553 * MiB;
constexpr size_t WS_XS = 368 * MiB;
constexpr size_t WS_ACT = 512 * MiB;
constexpr size_t WS_YB = 656 * MiB;
constexpr int CW_BAR = 4096;
constexpr int CW_Q = 4096 + 3600;
constexpr int CW_CNT = 8192, CW_CURSOR = 8192 + 64;
constexpr int SM_TOPI = 0, SM_TOPG = 65536, SM_ROWGATE = 131072, SM_PAIRROW = 131072 + 73728, SM_HIST = 131072 + 73728 + 65536, SM_ROWTOK = 131072 + 73728 + 65536 + 8192;

__device__ __forceinline__ float sigmoidf_(float x) { return 1.f / (1.f + __expf(-x)); }
__device__ __forceinline__ unsigned f2bf(float f) { unsigned u = __builtin_bit_cast(unsigned, f); return (u + 0x7fffu + ((u >> 16) & 1u)) >> 16; }
__device__ __forceinline__ unsigned pk2(float lo, float hi) { return f2bf(lo) | (f2bf(hi) << 16); }
__device__ __forceinline__ float bf2f(unsigned short b) { return __builtin_bit_cast(float, (unsigned)b << 16); }
#define XB_TMO      128
#define XB_XCNT(j)  (256  + 64 * (j))
#define XB_XSUB(j)  (1280 + 64 * (j))
#define XB_XGEN(j)  (2304 + 64 * (j))
#define XB_TOP      3328
#define XB_TOPGEN   3392
#define XCD_BAR_WORDS 3456
#define XB_SPIN_CAP (1u << 18)

__device__ __forceinline__ unsigned xb_ld(unsigned* p)              { return __hip_atomic_load(p, __ATOMIC_RELAXED, __HIP_MEMORY_SCOPE_AGENT); }
__device__ __forceinline__ unsigned xb_add(unsigned* p, unsigned v) { return __hip_atomic_fetch_add(p, v, __ATOMIC_RELAXED, __HIP_MEMORY_SCOPE_AGENT); }
__device__ __forceinline__ unsigned xb_xcc_id() { return (unsigned)__builtin_amdgcn_s_getreg((3 << 11) | 20) & 0xFu; }
#define XB_SPIN(cond, bar) do { unsigned _sp = 0; while (cond) { __builtin_amdgcn_s_sleep(1); \
    if ((++_sp & 255u) == 0u) { if (xb_ld(&(bar)[XB_TMO])) break; if (_sp > XB_SPIN_CAP) { atomicAdd(&(bar)[XB_TMO], 1u); break; } } } } while (0)

struct XcdBarrier {
    unsigned* bar; unsigned x; int w0;
    volatile LAS unsigned* st;
};

__device__ __forceinline__ XcdBarrier xcd_barrier_post(unsigned* bar, volatile LAS unsigned* st) {
    XcdBarrier b; b.bar = bar; b.x = xb_xcc_id(); b.st = st;
    if (threadIdx.x == 0) (void)xb_add(&bar[XB_XCNT(b.x)], 1u);
    return b;
}
__device__ __forceinline__ void xcd_barrier_complete(unsigned* bar, unsigned x, unsigned& nloc, unsigned& nx) {
    const unsigned G = gridDim.x * gridDim.y * gridDim.z;
    unsigned sum, cnt, mine, sp = 0u;
    for (;;) {
        sum = 0u; cnt = 0u; mine = 0u;
#pragma unroll
        for (unsigned j = 0; j < 16; ++j) { const unsigned c = xb_ld(&bar[XB_XCNT(j)]); sum += c; cnt += (c > 0u) ? 1u : 0u; mine = (j == x) ? c : mine; }
        if (sum == G) break;
        __builtin_amdgcn_s_sleep(1);
        if ((++sp & 255u) == 0u) { if (xb_ld(&bar[XB_TMO])) break; if (sp > XB_SPIN_CAP) { atomicAdd(&bar[XB_TMO], 1u); break; } }
    }
    nloc = mine > 0u ? mine : 1u; nx = cnt > 0u ? cnt : 1u;
}

__device__ __forceinline__ void xcd_barrier(const XcdBarrier& b) {
    asm volatile("s_waitcnt vmcnt(0)" ::: "memory");
    __syncthreads();
    if (b.w0 == 0 && hw_lane_id() == 0) {
        unsigned* bar = b.bar;
        __builtin_amdgcn_s_waitcnt(0);
        unsigned nloc = b.st[0], nx = b.st[1];
        if (nloc == 0u) { xcd_barrier_complete(bar, b.x, nloc, nx); b.st[0] = nloc; b.st[1] = nx; }
        const unsigned old = xb_add(&bar[XB_XSUB(b.x)], 1u);
        const unsigned gen = old / nloc;
        if (old + 1u == (gen + 1u) * nloc) {
            __builtin_amdgcn_fence(__ATOMIC_RELEASE, "agent");
            asm volatile("s_waitcnt vmcnt(0)" ::: "memory");
            const unsigned og = xb_add(&bar[XB_TOP], 1u);
            const unsigned tg = og / nx;
            if (og + 1u == (tg + 1u) * nx) xb_add(&bar[XB_TOPGEN], 1u);
            else XB_SPIN(xb_ld(&bar[XB_TOPGEN]) == tg, bar);
            __builtin_amdgcn_fence(__ATOMIC_ACQUIRE, "agent");
            xb_add(&bar[XB_XGEN(b.x)], 1u);
            asm volatile("s_waitcnt vmcnt(0)" ::: "memory");
        } else {
            XB_SPIN(xb_ld(&bar[XB_XGEN(b.x)]) == gen, bar);
            __builtin_amdgcn_fence(__ATOMIC_ACQUIRE, "agent");
            asm volatile("s_waitcnt vmcnt(0)" ::: "memory");
        }
    }
    __syncthreads();
}

struct MapPlain { int off; __device__ __forceinline__ int operator()(int n) const { return off + n; } };
struct MapGU { int e; __device__ __forceinline__ int operator()(int oc) const { const int a = oc >> 1, gl = oc & 1; return e * 2048 + (a >> 7) * 256 + gl * 128 + (a & 127); } };
struct MapDN { int e; __device__ __forceinline__ int operator()(int n) const { return e * 1024 + (n & ~255) + ((n >> 3) & 1) * 128 + ((n >> 6) & 3) * 32 + ((n >> 4) & 3) * 8 + (n & 7); } };
template <class Map>
__device__ __forceinline__ void transpose_item(const float* W, int K, int N, bf16_t* WT, const Map& map, LAS float* scr, int item, int lane) {
    const int nblk = N / 32, kb = item / nblk, nb = item % nblk, k0 = 64 * kb, n0 = 32 * nb;
#pragma unroll 8
    for (int i = 0; i < 32; ++i) { const int kk = 2 * i + (lane >> 5); scr[kk * 33 + (lane & 31)] = W[(size_t)(k0 + kk) * N + n0 + (lane & 31)]; }
    asm volatile("s_waitcnt lgkmcnt(0)" ::: "memory");
    const int c = lane & 7;
#pragma unroll
    for (int j = 0; j < 4; ++j) { const int n = (lane >> 3) + 8 * j; const LAS float* s = scr + (8 * c) * 33 + n;
        v4u o; o.x = pk2(s[0 * 33], s[1 * 33]); o.y = pk2(s[2 * 33], s[3 * 33]); o.z = pk2(s[4 * 33], s[5 * 33]); o.w = pk2(s[6 * 33], s[7 * 33]);
        *(v4u*)(WT + (size_t)map(n0 + n) * K + k0 + 8 * c) = o; }
    asm volatile("s_waitcnt lgkmcnt(0)" ::: "memory");
}

template <class Map, bool DEEP = false>
__device__ __forceinline__ void transpose_item8(const float* W, int K, int N, unsigned char* WT, const Map& map, LAS float* scr, int item, int lane) {
    const int nblk = N / 32, kb = item / nblk, nb = item % nblk, k0 = 64 * kb, n0 = 32 * nb;
    if constexpr (DEEP) {
#pragma unroll
        for (int i = 0; i < 32; ++i) { const int kk = 2 * i + (lane >> 5); scr[kk * 33 + (lane & 31)] = __builtin_nontemporal_load(W + (size_t)(k0 + kk) * N + n0 + (lane & 31)); }
    } else {
#pragma unroll 8
    for (int i = 0; i < 32; ++i) { const int kk = 2 * i + (lane >> 5); scr[kk * 33 + (lane & 31)] = __builtin_nontemporal_load(W + (size_t)(k0 + kk) * N + n0 + (lane & 31)); }
    }
    asm volatile("s_waitcnt lgkmcnt(0)" ::: "memory");
    const int c = lane & 7;
    typedef unsigned u32x2 __attribute__((ext_vector_type(2)));
#pragma unroll
    for (int j = 0; j < 4; ++j) { const int n = (lane >> 3) + 8 * j; const LAS float* s = scr + (8 * c) * 33 + n;
        u32x2 o; o.x = pg8::pk4_fp8(s[0 * 33] * 32.f, s[1 * 33] * 32.f, s[2 * 33] * 32.f, s[3 * 33] * 32.f); o.y = pg8::pk4_fp8(s[4 * 33] * 32.f, s[5 * 33] * 32.f, s[6 * 33] * 32.f, s[7 * 33] * 32.f);
        __builtin_nontemporal_store(o, (u32x2*)(WT + (size_t)map(n0 + n) * K + k0 + 8 * c)); }
    asm volatile("s_waitcnt lgkmcnt(0)" ::: "memory");
}
__device__ __forceinline__ void rms_row_to_bf16(const float* xrow, const float* w, bf16_t* orow, int lane) {
    const f32x4* xr = (const f32x4*)xrow + lane; const f32x4* wr = (const f32x4*)w + lane;
    f32x4 v[4]; float s = 0.f;
#pragma unroll
    for (int j = 0; j < 4; ++j) { v[j] = xr[64 * j]; s += (v[j].x * v[j].x + v[j].y * v[j].y) + (v[j].z * v[j].z + v[j].w * v[j].w); }
    s = rk::wsum(s);
    const float r = rsqrtf(s * (1.f / D_) + 1e-5f);
    unsigned long long* o8 = (unsigned long long*)orow + lane;
#pragma unroll
    for (int j = 0; j < 4; ++j) { const f32x4 ww = wr[64 * j]; o8[64 * j] = (unsigned long long)pk2(v[j].x * r * ww.x, v[j].y * r * ww.y) | ((unsigned long long)pk2(v[j].z * r * ww.z, v[j].w * r * ww.w) << 32); }
}

struct Args {
    const float *x, *nmw, *w_in, *conv_w, *mu, *w0, *wdu, *a0, *wiu, *wgu, *k_k, *k_a, *r_k, *lnw, *lnb, *w_out, *nfw, *rw, *rb, *gu_w, *gu_b, *dn_w, *dn_b, *nfinal;
    float* out; unsigned char* ws;
};

__device__ __forceinline__ void conv_rows(const bf16_t* __restrict__ P, const float* __restrict__ cw, bf16_t* __restrict__ ymix, int gw, int ngw, int lane) {
    const int c0 = lane * 8;
    float w0[8], w1[8], w2[8];
#pragma unroll
    for (int i = 0; i < 8; ++i) { w0[i] = cw[c0 + i]; w1[i] = cw[CW + c0 + i]; w2[i] = cw[2 * CW + c0 + i]; }
    for (int row = gw; row < T_; row += 2 * ngw) {
        v4u cb[2], cc[2][3], ch[2][3]; bool valid[2]; int tt[2], rq[2];
#pragma unroll
        for (int q = 0; q < 2; ++q) {
            const int rowq = row + q * ngw; valid[q] = rowq < T_; rq[q] = valid[q] ? rowq : row;
            const int t = rq[q] % S_; tt[q] = t;
            const bf16_t* pr = P + (size_t)rq[q] * INC + c0;
            const int o1 = (t >= 1) ? INC : 0, o2 = (t >= 2) ? 2 * INC : 0;
            cb[q] = *(const v4u*)pr; cc[q][0] = *(const v4u*)(pr + CW); ch[q][0] = *(const v4u*)(pr + 2 * CW);
            cc[q][1] = *(const v4u*)(pr - o1 + CW); ch[q][1] = *(const v4u*)(pr - o1 + 2 * CW);
            cc[q][2] = *(const v4u*)(pr - o2 + CW); ch[q][2] = *(const v4u*)(pr - o2 + 2 * CW);
        }
#pragma unroll
        for (int q = 0; q < 2; ++q) {
            const v4u zero4 = {0, 0, 0, 0};
            const v4u cc1 = (tt[q] >= 1) ? cc[q][1] : zero4, ch1 = (tt[q] >= 1) ? ch[q][1] : zero4, cc2 = (tt[q] >= 2) ? cc[q][2] : zero4, ch2 = (tt[q] >= 2) ? ch[q][2] : zero4;
            const unsigned b_[4] = {cb[q].x, cb[q].y, cb[q].z, cb[q].w}, a0[4] = {cc[q][0].x, cc[q][0].y, cc[q][0].z, cc[q][0].w}, h0[4] = {ch[q][0].x, ch[q][0].y, ch[q][0].z, ch[q][0].w};
            const unsigned a1[4] = {cc1.x, cc1.y, cc1.z, cc1.w}, h1[4] = {ch1.x, ch1.y, ch1.z, ch1.w}, a2[4] = {cc2.x, cc2.y, cc2.z, cc2.w}, h2[4] = {ch2.x, ch2.y, ch2.z, ch2.w};
            unsigned o[4];
#pragma unroll
            for (int i = 0; i < 4; ++i) {
                const float u0l = rk::blo(a0[i]) * rk::blo(h0[i]), u0h = rk::bhi(a0[i]) * rk::bhi(h0[i]);
                const float u1l = rk::blo(a1[i]) * rk::blo(h1[i]), u1h = rk::bhi(a1[i]) * rk::bhi(h1[i]);
                const float u2l = rk::blo(a2[i]) * rk::blo(h2[i]), u2h = rk::bhi(a2[i]) * rk::bhi(h2[i]);
                const float yl = w0[2 * i] * u2l + w1[2 * i] * u1l + w2[2 * i] * u0l, yh = w0[2 * i + 1] * u2h + w1[2 * i + 1] * u1h + w2[2 * i + 1] * u0h;
                o[i] = pk2(rk::blo(b_[i]) * yl, rk::bhi(b_[i]) * yh);
            }
            if (valid[q]) __builtin_nontemporal_store((v4u){o[0], o[1], o[2], o[3]}, (v4u*)(ymix + (size_t)rq[q] * D_ + c0));
        }
    }
}
__device__ __forceinline__ void router_rows2(const bf16_t* h1, const float* nfw, const float* rb, int row0, int lane, bf16_t* xn2, int* sm, LAS unsigned* cnt, const LAS float* wl, bool docount) {
    f32x4 v[2][4];
#pragma unroll
    for (int r = 0; r < 2; ++r) {
        const unsigned long long* xr = (const unsigned long long*)(h1 + (size_t)(row0 + r) * D_);
        float s = 0.f;
#pragma unroll
        for (int j = 0; j < 4; ++j) { const unsigned long long tq = xr[lane + 64 * j];
            v[r][j] = (f32x4){bf2f((unsigned short)tq), bf2f((unsigned short)(tq >> 16)), bf2f((unsigned short)(tq >> 32)), bf2f((unsigned short)(tq >> 48))};
            s += v[r][j].x * v[r][j].x + v[r][j].y * v[r][j].y + v[r][j].z * v[r][j].z + v[r][j].w * v[r][j].w; }
        s = rk::wsum(s);
        const float rs = rsqrtf(s * (1.f / D_) + 1e-5f);
        unsigned* o4 = (unsigned*)((unsigned char*)xn2 + (size_t)(row0 + r) * D_);
        const f32x4* wr = (const f32x4*)nfw;
#pragma unroll
        for (int j = 0; j < 4; ++j) { const f32x4 ww = wr[lane + 64 * j]; v[r][j].x *= rs * ww.x; v[r][j].y *= rs * ww.y; v[r][j].z *= rs * ww.z; v[r][j].w *= rs * ww.w;
            o4[lane + 64 * j] = pg8::pk4_fp8(v[r][j].x, v[r][j].y, v[r][j].z, v[r][j].w); }
    }
    float pa[2][32];
#pragma unroll
    for (int r = 0; r < 2; ++r)
#pragma unroll
        for (int e = 0; e < 32; ++e) pa[r][e] = 0.f;
#pragma unroll 1
    for (int j = 0; j < 4; ++j) {
        const float xv[2][4] = {{v[0][j].x, v[0][j].y, v[0][j].z, v[0][j].w}, {v[1][j].x, v[1][j].y, v[1][j].z, v[1][j].w}};
#pragma unroll
        for (int q = 0; q < 4; ++q) {
            const LAS f32x4* wrow = (const LAS f32x4*)(wl + (q * 256 + lane + 64 * j) * 36);
#pragma unroll
            for (int eh = 0; eh < 2; ++eh) {
#pragma unroll
                for (int e4 = 4 * eh; e4 < 4 * eh + 4; ++e4) { const f32x4 w4 = wrow[e4];
#pragma unroll
                    for (int r = 0; r < 2; ++r) { pa[r][4 * e4 + 0] += xv[r][q] * w4.x; pa[r][4 * e4 + 1] += xv[r][q] * w4.y; pa[r][4 * e4 + 2] += xv[r][q] * w4.z; pa[r][4 * e4 + 3] += xv[r][q] * w4.w; } }
                asm volatile("" ::: "memory");
            }
        }
    }
#pragma unroll
    for (int r = 0; r < 2; ++r) {
        float t16[16], t8[8], t4[4], t2[2], t1;
        { const bool h = (lane & 32) != 0;
#pragma unroll
          for (int i = 0; i < 16; ++i) { const float mine = h ? pa[r][16 + i] : pa[r][i], send = h ? pa[r][i] : pa[r][16 + i]; t16[i] = mine + __shfl_xor(send, 32); } }
        { const bool h = (lane & 16) != 0;
#pragma unroll
          for (int i = 0; i < 8; ++i) { const float mine = h ? t16[8 + i] : t16[i], send = h ? t16[i] : t16[8 + i]; t8[i] = mine + __shfl_xor(send, 16); } }
        { const bool h = (lane & 8) != 0;
#pragma unroll
          for (int i = 0; i < 4; ++i) { const float mine = h ? t8[4 + i] : t8[i], send = h ? t8[i] : t8[4 + i]; t4[i] = mine + __shfl_xor(send, 8); } }
        { const bool h = (lane & 4) != 0;
#pragma unroll
          for (int i = 0; i < 2; ++i) { const float mine = h ? t4[2 + i] : t4[i], send = h ? t4[i] : t4[2 + i]; t2[i] = mine + __shfl_xor(send, 4); } }
        { const bool h = (lane & 2) != 0; const float mine = h ? t2[1] : t2[0], send = h ? t2[0] : t2[1]; t1 = mine + __shfl_xor(send, 2); }
        t1 += __shfl_xor(t1, 1);
        const int me = lane >> 1;
        float mylogit = (lane & 1) ? -INFINITY : t1 + rb[me];
        float best[4]; int bi[4];
#pragma unroll
        for (int k = 0; k < 4; ++k) {
            float bv = mylogit; int bidx = (lane & 1) ? 1000 : me;
#pragma unroll
            for (int o = 1; o < 64; o <<= 1) { const float ov = __shfl_xor(bv, o); const int oi = __shfl_xor(bidx, o); if (ov > bv || (ov == bv && oi < bidx)) { bv = ov; bidx = oi; } }
            best[k] = bv; bi[k] = bidx;
            if (!(lane & 1) && me == bidx) mylogit = -INFINITY;
        }
        const float mx = best[0];
        float ex[4], den = 0.f;
#pragma unroll
        for (int k = 0; k < 4; ++k) { ex[k] = __expf(best[k] - mx); den += ex[k]; }
        if (lane < 4) {
            const float gsel = lane == 0 ? ex[0] : lane == 1 ? ex[1] : lane == 2 ? ex[2] : ex[3];
            const int isel = lane == 0 ? bi[0] : lane == 1 ? bi[1] : lane == 2 ? bi[2] : bi[3];
            sm[SM_TOPI + (row0 + r) * 4 + lane] = isel; ((float*)sm)[SM_TOPG + (row0 + r) * 4 + lane] = gsel / den;
            if (docount) __hip_atomic_fetch_add(&cnt[isel], 1u, __ATOMIC_RELAXED, __HIP_MEMORY_SCOPE_WORKGROUP);
        }
    }
}
__device__ __forceinline__ void final_row(const bf16_t* h1, const unsigned char* yb, const float* nfinal, float* out, int row, int lane, const int (&pr4)[4]) {
    const unsigned long long* xr = (const unsigned long long*)(h1 + (size_t)row * D_);
    f32x4 v[4], a[4];
#pragma unroll
    for (int j = 0; j < 4; ++j) { const unsigned long long tq = xr[lane + 64 * j]; v[j] = (f32x4){bf2f((unsigned short)tq), bf2f((unsigned short)(tq >> 16)), bf2f((unsigned short)(tq >> 32)), bf2f((unsigned short)(tq >> 48))}; a[j] = (f32x4){0.f, 0.f, 0.f, 0.f}; }
#pragma unroll
    for (int k = 0; k < 4; ++k) {
        const unsigned* yr = (const unsigned*)(yb + (size_t)pr4[k] * D_);
#pragma unroll
        for (int j = 0; j < 4; ++j) { const unsigned t = __builtin_nontemporal_load(yr + lane + 64 * j);
            const auto lo = __builtin_amdgcn_cvt_pk_f32_fp8((int)t, false), hi = __builtin_amdgcn_cvt_pk_f32_fp8((int)t, true);
            a[j].x += lo[0]; a[j].y += lo[1]; a[j].z += hi[0]; a[j].w += hi[1]; }
    }
    float s = 0.f;
#pragma unroll
    for (int j = 0; j < 4; ++j) { v[j] = v[j] + a[j] * 0.03125f; s += v[j].x * v[j].x + v[j].y * v[j].y + v[j].z * v[j].z + v[j].w * v[j].w; }
    s = rk::wsum(s);
    const float r = rsqrtf(s * (1.f / D_) + 1e-5f);
    f32x4* yo = (f32x4*)(out + (size_t)row * D_);
    const f32x4* wr = (const f32x4*)nfinal;
#pragma unroll
    for (int j = 0; j < 4; ++j) { f32x4 ww = wr[lane + 64 * j]; __builtin_nontemporal_store((f32x4){v[j].x * r * ww.x, v[j].y * r * ww.y, v[j].z * r * ww.z, v[j].w * r * ww.w}, yo + lane + 64 * j); }
}


constexpr int RT_PL = 0, RT_PS = 65536, RT_LG = 65536 + 2048, RT_RS = RT_LG + 8192, RT_SEL = RT_RS + 256, RT_HIST = RT_SEL + 2048, RT_NFW = RT_HIST + 256, RT_RB = RT_NFW + 4096, RT_KEEP = RT_RB + 256;
__device__ __forceinline__ void router_block(const bf16_t* h1, const bf16_t* w2, const float* nfw, const float* rb, bf16_t* xn2, int* sm, LAS unsigned char* lds, int bid, int wave, int lane) {
    typedef short bf16x8 __attribute__((ext_vector_type(8))); typedef float f32x16 __attribute__((ext_vector_type(16)));
    const int r32 = lane & 31, hh = lane >> 5, row0 = bid * 64, k0 = wave * 128;
    LAS float* PL = (LAS float*)(lds + RT_PL); LAS float* PS = (LAS float*)(lds + RT_PS); LAS float* LG = (LAS float*)(lds + RT_LG); LAS float* RS = (LAS float*)(lds + RT_RS);
    LAS float* SEL = (LAS float*)(lds + RT_SEL); LAS unsigned* hist = (LAS unsigned*)(lds + RT_HIST);
    if (wave == 0 && lane < 32) hist[lane] = 0u;
    bf16x8 a[2][8], wh[8], wl[8];
#pragma unroll
    for (int rt = 0; rt < 2; ++rt)
#pragma unroll
        for (int s = 0; s < 8; ++s) a[rt][s] = *(const bf16x8*)(h1 + (size_t)(row0 + 32 * rt + r32) * D_ + k0 + 16 * s + 8 * hh);
#pragma unroll
    for (int s = 0; s < 8; ++s) { wh[s] = *(const bf16x8*)(w2 + (size_t)r32 * D_ + k0 + 16 * s + 8 * hh); wl[s] = *(const bf16x8*)(w2 + (size_t)(32 + r32) * D_ + k0 + 16 * s + 8 * hh); }
    { const int tid = wave * 64 + lane;
      if (tid < 256) *(LAS f32x4*)(lds + RT_NFW + tid * 16) = *(const f32x4*)(nfw + 4 * tid);
      else if (tid < 264) *(LAS f32x4*)(lds + RT_RB + (tid - 256) * 16) = *(const f32x4*)(rb + 4 * (tid - 256)); }
    f32x16 acc[2];
#pragma unroll
    for (int rt = 0; rt < 2; ++rt)
#pragma unroll
        for (int q = 0; q < 16; ++q) acc[rt][q] = 0.f;
#pragma unroll
    for (int s = 0; s < 8; ++s) {
        const bf16x8 bh = wh[s], bl = wl[s];
#pragma unroll
        for (int rt = 0; rt < 2; ++rt) { acc[rt] = __builtin_amdgcn_mfma_f32_32x32x16_bf16(a[rt][s], bh, acc[rt], 0, 0, 0); acc[rt] = __builtin_amdgcn_mfma_f32_32x32x16_bf16(a[rt][s], bl, acc[rt], 0, 0, 0); }
    }
#pragma unroll
    for (int rt = 0; rt < 2; ++rt) {
        float s2 = 0.f;
#pragma unroll
        for (int s = 0; s < 8; ++s) { const v4u u = __builtin_bit_cast(v4u, a[rt][s]);
            const float x0 = rk::blo(u.x), x1 = rk::bhi(u.x), x2 = rk::blo(u.y), x3 = rk::bhi(u.y), x4 = rk::blo(u.z), x5 = rk::bhi(u.z), x6 = rk::blo(u.w), x7 = rk::bhi(u.w);
            s2 += (x0 * x0 + x1 * x1) + (x2 * x2 + x3 * x3) + (x4 * x4 + x5 * x5) + (x6 * x6 + x7 * x7); }
        s2 += __shfl_xor(s2, 32);
        if (hh == 0) PS[wave * 64 + 32 * rt + r32] = s2;
#pragma unroll
        for (int q = 0; q < 16; ++q) PL[(wave * 64 + 32 * rt + rk::drow(q, hh)) * 32 + r32] = acc[rt][q];
    }
    __syncthreads();
    { const int tid = wave * 64 + lane;
      if (tid < 64) { float s = 0.f;
#pragma unroll
          for (int w2i = 0; w2i < 8; ++w2i) s += PS[w2i * 64 + tid];
          RS[tid] = rsqrtf(s * (1.f / D_) + 1e-5f); }
#pragma unroll
      for (int i = 0; i < 4; ++i) { const int idx = tid + 512 * i; float s = 0.f;
#pragma unroll
          for (int w2i = 0; w2i < 8; ++w2i) s += PL[w2i * 2048 + idx];
          LG[idx] = s; } }
    __syncthreads();
    {
        const int rl = 8 * wave + (lane >> 3), eg = lane & 7; const float rs = RS[rl];
        float mine[4];
        const LAS float* rbl = (const LAS float*)(lds + RT_RB);
#pragma unroll
        for (int i = 0; i < 4; ++i) mine[i] = LG[rl * 32 + 4 * eg + i] * rs + rbl[4 * eg + i];
        int rank[4] = {0, 0, 0, 0};
#pragma unroll
        for (int e4 = 0; e4 < 8; ++e4) { const f32x4 o4 = *(const LAS f32x4*)(LG + rl * 32 + 4 * e4); const f32x4 b4 = *(const LAS f32x4*)(rbl + 4 * e4);
#pragma unroll
            for (int jj = 0; jj < 4; ++jj) { const float ov = o4[jj] * rs + b4[jj]; const int oe = 4 * e4 + jj;
#pragma unroll
                for (int i = 0; i < 4; ++i) { const int me = 4 * eg + i; rank[i] += (ov > mine[i] || (ov == mine[i] && oe < me)) ? 1 : 0; } } }
#pragma unroll
        for (int i = 0; i < 4; ++i) if (rank[i] < 4) { SEL[(rl * 4 + rank[i]) * 2] = mine[i]; ((LAS int*)SEL)[(rl * 4 + rank[i]) * 2 + 1] = 4 * eg + i; }
        asm volatile("s_waitcnt lgkmcnt(0)" ::: "memory");
        if (eg < 4) {
            const float v0 = SEL[(rl * 4 + 0) * 2], v1 = SEL[(rl * 4 + 1) * 2], v2 = SEL[(rl * 4 + 2) * 2], v3 = SEL[(rl * 4 + 3) * 2];
            const float e0 = 1.f, e1 = __expf(v1 - v0), e2 = __expf(v2 - v0), e3 = __expf(v3 - v0), den = (e0 + e1) + (e2 + e3);
            const float gsel = (eg == 0 ? e0 : eg == 1 ? e1 : eg == 2 ? e2 : e3) / den; const int isel = ((const LAS int*)SEL)[(rl * 4 + eg) * 2 + 1];
            ((LAS int*)(lds + RT_KEEP))[(rl * 4 + eg) * 2] = isel; ((LAS float*)(lds + RT_KEEP))[(rl * 4 + eg) * 2 + 1] = gsel;
            __hip_atomic_fetch_add(&hist[isel], 1u, __ATOMIC_RELAXED, __HIP_MEMORY_SCOPE_WORKGROUP);
        }
    }
#pragma unroll
    for (int rt = 0; rt < 2; ++rt) { const float rs = RS[32 * rt + r32];
#pragma unroll
        for (int s = 0; s < 8; ++s) { const v4u u = __builtin_bit_cast(v4u, a[rt][s]); const int k = k0 + 16 * s + 8 * hh;
            const f32x4 n0 = *(const LAS f32x4*)(lds + RT_NFW + k * 4), n1 = *(const LAS f32x4*)(lds + RT_NFW + (k + 4) * 4);
            typedef unsigned u32x2 __attribute__((ext_vector_type(2)));
            *(u32x2*)((unsigned char*)xn2 + (size_t)(row0 + 32 * rt + r32) * D_ + k) = (u32x2){
                pg8::pk4_fp8(rk::blo(u.x) * rs * n0[0], rk::bhi(u.x) * rs * n0[1], rk::blo(u.y) * rs * n0[2], rk::bhi(u.y) * rs * n0[3]),
                pg8::pk4_fp8(rk::blo(u.z) * rs * n1[0], rk::bhi(u.z) * rs * n1[1], rk::blo(u.w) * rs * n1[2], rk::bhi(u.w) * rs * n1[3])}; } }
    __syncthreads();
    { const int tid = wave * 64 + lane; if (tid < 32) sm[SM_HIST + bid * 32 + tid] = (int)hist[tid]; }
}
typedef __attribute__((address_space(4))) const char* kcptr;
template <class T> __device__ __forceinline__ T karg(int off) { kcptr k = (kcptr)__builtin_amdgcn_kernarg_segment_ptr(); asm volatile("" : "+s"(k)); return *(__attribute__((address_space(4))) const T*)(k + off); }
#define KA(f) karg<decltype(Args::f)>((int)offsetof(Args, f))
__global__ void __launch_bounds__(NTHR, 2) mega_fwd(Args a) {
    extern __shared__ __attribute__((aligned(16))) unsigned char lds_raw[];
    LAS unsigned char* lds = (LAS unsigned char*)lds_raw;
    volatile LAS unsigned* MISC = (volatile LAS unsigned*)(lds + MISC_OFF);
#define PHASE_IDS() int lane = hw_lane_id(); asm volatile("" : "+v"(lane)); const int wave = wave_s, tid = wave * 64 + lane; const int gw = bid * NWAVES + wave, NGW = G * NWAVES; (void)tid; (void)gw; (void)NGW
    const int bid = blockIdx.x, G = gridDim.x;
    const int wave_s = __builtin_amdgcn_readfirstlane((int)threadIdx.x >> 6);
    unsigned char* ws = KA(ws);
    unsigned* ctl = (unsigned*)(ws + WS_CTL);
    int* sm = (int*)(ws + WS_SMALL);
    for (int u = threadIdx.x; u < 64; u += NTHR) MISC[u] = 0u;
    __syncthreads();
    XcdBarrier bar = xcd_barrier_post(ctl + CW_BAR, MISC + 8); bar.w0 = wave_s;
    bf16_t* WIN = (bf16_t*)(ws + WS_WIN); bf16_t* WOUT = (bf16_t*)(ws + WS_WOUT); bf16_t* WGU = (bf16_t*)(ws + WS_WGU); bf16_t* WDN = (bf16_t*)(ws + WS_WDN);
    bf16_t* XN = (bf16_t*)(ws + WS_XN); bf16_t* LORA = (bf16_t*)(ws + WS_LORA); bf16_t* P = (bf16_t*)(ws + WS_P); bf16_t* YMIX = (bf16_t*)(ws + WS_YMIX);

    for (int rep = 0; rep < REP_P0; ++rep) {
        PHASE_IDS();
        LAS float* scr = (LAS float*)(lds + wave * 16384);
        constexpr int I_IN = (D_ / 64) * (INC / 32), I_OUT = (D_ / 64) * (D_ / 32), I_GU = (D_ / 64) * (2 * FF / 32), I_DN = (FF / 64) * (D_ / 32);
        constexpr int NGU0 = E_ * I_GU - P3_ITEMS;
        constexpr int NITEMS = I_IN + I_OUT + NGU0;
        const float* w_in_ = KA(w_in); const float* w_out_ = KA(w_out); const float* gu_w_ = KA(gu_w); const float* dn_w_ = KA(dn_w);
        for (int it = gw; it < NITEMS; it += NGW) {
            int r = it;
            if (r < I_IN) { transpose_item(w_in_, D_, INC, WIN, MapPlain{0}, scr, r, lane); continue; } r -= I_IN;
            if (r < I_OUT) { transpose_item(w_out_, D_, D_, WOUT, MapPlain{0}, scr, r, lane); continue; } r -= I_OUT;
            if (r < NGU0) { const int e = r / I_GU; transpose_item8(gu_w_ + (size_t)e * D_ * 2 * FF, D_, 2 * FF, (unsigned char*)WGU, MapGU{e}, scr, r % I_GU, lane); continue; } r -= NGU0;
            { const int e = r / I_DN; transpose_item8(dn_w_ + (size_t)e * FF * D_, FF, D_, (unsigned char*)WDN, MapDN{e}, scr, r % I_DN, lane); }
        }
        { const float* x_ = KA(x); const float* nmw_ = KA(nmw);
          for (int m = gw; m < T_; m += 2 * NGW) {
              const f32x4* xa = (const f32x4*)(x_ + (size_t)m * D_) + lane; const f32x4* xb = (const f32x4*)(x_ + (size_t)(m + NGW) * D_) + lane; const f32x4* wr = (const f32x4*)nmw_ + lane;
              f32x4 va[4], vb[4]; float sa = 0.f, sb = 0.f;
#pragma unroll
              for (int j = 0; j < 4; ++j) { va[j] = __builtin_nontemporal_load(xa + 64 * j); vb[j] = __builtin_nontemporal_load(xb + 64 * j); }
#pragma unroll
              for (int j = 0; j < 4; ++j) { sa += (va[j].x * va[j].x + va[j].y * va[j].y) + (va[j].z * va[j].z + va[j].w * va[j].w); sb += (vb[j].x * vb[j].x + vb[j].y * vb[j].y) + (vb[j].z * vb[j].z + vb[j].w * vb[j].w); }
              sa = rk::wsum(sa); sb = rk::wsum(sb);
              const float ra = rsqrtf(sa * (1.f / D_) + 1e-5f), rb2 = rsqrtf(sb * (1.f / D_) + 1e-5f);
              if (lane == 0) { float* irs_ = (float*)(ws + WS_SMALL + 3 * MiB); irs_[m] = __builtin_amdgcn_rcpf(ra); irs_[m + NGW] = __builtin_amdgcn_rcpf(rb2); }
              unsigned long long* oa = (unsigned long long*)(XN + (size_t)m * D_) + lane; unsigned long long* ob = (unsigned long long*)(XN + (size_t)(m + NGW) * D_) + lane;
#pragma unroll
              for (int j = 0; j < 4; ++j) { const f32x4 ww = wr[64 * j];
                  oa[64 * j] = (unsigned long long)pk2(va[j].x * ra * ww.x, va[j].y * ra * ww.y) | ((unsigned long long)pk2(va[j].z * ra * ww.z, va[j].w * ra * ww.w) << 32);
                  ob[64 * j] = (unsigned long long)pk2(vb[j].x * rb2 * ww.x, vb[j].y * rb2 * ww.y) | ((unsigned long long)pk2(vb[j].z * rb2 * ww.z, vb[j].w * rb2 * ww.w) << 32); }
          } }
        { const float* rw_ = KA(rw); const float* nfw_ = KA(nfw); bf16_t* W2 = (bf16_t*)(ws + WS_W2);
          for (int idx = bid * NTHR + tid; idx < 32 * 1024; idx += G * NTHR) { const int e = idx >> 10, k = idx & 1023; const float v = rw_[k * 32 + e] * nfw_[k];
              const unsigned hb = f2bf(v); const float hf = bf2f((unsigned short)hb); W2[e * 1024 + k] = (bf16_t)hb; W2[(32 + e) * 1024 + k] = (bf16_t)f2bf(v - hf); } }
        const float* wdu_ = KA(wdu); const float* wiu_ = KA(wiu); const float* wgu_ = KA(wgu);
        for (int idx = bid * NTHR + tid; idx < 512 * 256; idx += G * NTHR) {
            const int c = idx >> 8, j = idx & 255;
            if (j < 64) LORA[c * 64 + j] = (bf16_t)f2bf(wdu_[j * 512 + c]);
            else if (j < 128) LORA[512 * 64 + c * 64 + (j - 64)] = (bf16_t)f2bf(wiu_[(j - 64) * 512 + c]);
            else LORA[2 * 512 * 64 + c * 128 + (j - 128)] = (bf16_t)f2bf(wgu_[(j - 128) * 512 + c]);
        }
    }
    xcd_barrier(bar);
    for (int rep = 0; rep < REP_G1; ++rep) {
        pg8::Gemm g{XN, WIN, T_, INC, D_}; pg8::StaticOrder S; S.init(T_, INC, G, bid);
        pg8::EpiBf16 E{P, INC};
        pg8::gemm_phase<pg8::EpiBf16, pg8::StaticOrder, true, true>(lds, g, S, E, wave_s);
        if (bid >= 64) {
            PHASE_IDS();
            constexpr int I_GU = (D_ / 64) * (2 * FF / 32); const float* gu_w_ = KA(gu_w); LAS float* scr = (LAS float*)(lds + wave * 16384);
            const int tw = (bid - 64) * NWAVES + wave;
            for (int it = tw; it < TAIL_GU; it += 192 * NWAVES) { const int r = E_ * I_GU - P3_ITEMS + it; const int e = r / I_GU;
                transpose_item8(gu_w_ + (size_t)e * D_ * 2 * FF, D_, 2 * FF, (unsigned char*)WGU, MapGU{e}, scr, r % I_GU, lane); }
            constexpr int I_DN = (FF / 64) * (D_ / 32); const float* dn_w_ = KA(dn_w);
            for (int it = tw; it < TAIL_ITEMS - TAIL_GU; it += 192 * NWAVES) { const int r = E_ * I_DN - (TAIL_ITEMS - TAIL_GU) + it; const int e = r / I_DN;
                transpose_item8(dn_w_ + (size_t)e * FF * D_, FF, D_, (unsigned char*)WDN, MapDN{e}, scr, r % I_DN, lane); }
        }
    }
    xcd_barrier(bar);
    {
        rk::R1Args r{P, KA(mu), KA(w0), KA(a0), KA(k_k), KA(k_a), KA(r_k), LORA, LORA + 512 * 64, ws + WS_UNITS, (float*)(ws + WS_GAM), (float*)(ws + WS_BON), nullptr};
        for (int bc = bid; bc < 256; bc += G) rk::r1_block(r, lds, bc, wave_s);
    }
    xcd_barrier(bar);
    for (int rep = 0; rep < REP_P3; ++rep) {
        PHASE_IDS();
        if (bid < 16) { rk::R2Args r{ws + WS_UNITS, (const float*)(ws + WS_GAM), ws + WS_ZS}; rk::r2_block(r, lds, bid, wave_s); if (REP_R2 > 1) rk::r2_block(r, lds, bid, wave_s); }
        else {
            conv_rows(P, KA(conv_w), YMIX, (bid - 16) * NWAVES + wave, (G - 16) * NWAVES, lane);
            constexpr int I_GU = (D_ / 64) * (2 * FF / 32); const float* gu_w_ = KA(gu_w); LAS float* scr = (LAS float*)(lds + wave * 16384);
            for (int it = (bid - 16) * NWAVES + wave; it < P3_ITEMS - TAIL_GU; it += (G - 16) * NWAVES) { const int r = E_ * I_GU - P3_ITEMS + TAIL_GU + it; const int e = r / I_GU;
                transpose_item8(gu_w_ + (size_t)e * D_ * 2 * FF, D_, 2 * FF, (unsigned char*)WGU, MapGU{e}, scr, r % I_GU, lane); }
        }
    }
    xcd_barrier(bar);
    {
        rk::R3Args r{P, KA(mu), KA(lnw), KA(lnb), LORA + 2 * 512 * 64, ws + WS_UNITS, ws + WS_ZS, (const float*)(ws + WS_BON), YMIX, nullptr, nullptr};
        for (int bc = bid; bc < 256; bc += G) { rk::r3_block(r, lds, bc, wave_s); __syncthreads(); }
    }
    xcd_barrier(bar);
    for (int rep = 0; rep < REP_G1; ++rep) {
        pg8::Gemm g{YMIX, WOUT, T_, D_, D_}; pg8::StaticOrder S; S.init(T_, D_, G, bid);
        pg8::EpiResXn E{XN, (const float*)(ws + WS_SMALL + 3 * MiB), KA(nmw), (bf16_t*)(ws + WS_H1), D_};
        pg8::gemm_phase<pg8::EpiResXn, pg8::StaticOrder, true, true>(lds, g, S, E, wave_s);
    }
    xcd_barrier(bar);
    { PHASE_IDS();
      router_block((const bf16_t*)(ws + WS_H1), (const bf16_t*)(ws + WS_W2), KA(nfw), KA(rb), XN, sm, lds, bid, wave, lane);
    }
    xcd_barrier(bar);
    LAS int* tl = (LAS int*)(lds + 131072);
    {
        PHASE_IDS();
        LAS int* part = tl + 512;
        { const int e = tid & 31, pt = tid >> 5; int sb = 0, sa = 0;
          for (int w2 = pt * 16; w2 < pt * 16 + 16; ++w2) { const int v = sm[SM_HIST + w2 * 32 + e]; sa += v; if (w2 < bid) sb += v; }
          part[pt * 64 + e] = sb; part[pt * 64 + 32 + e] = sa; }
        __syncthreads();
        if (tid < 32) { int sb = 0, sa = 0; for (int pt = 0; pt < 16; ++pt) { sb += part[pt * 64 + tid]; sa += part[pt * 64 + 32 + tid]; } tl[416 + tid] = sb; tl[448 + tid] = sa; tl[480 + tid] = 0; }
        __syncthreads();
        if (tid < 32) {
            const int e = tid; int acc = 0, mine = 0, tot = 0;
#pragma unroll
            for (int e2 = 0; e2 < E_; ++e2) { const int tl2 = (tl[448 + e2] + 255) / 256; tot += tl2; if (e2 < e) acc += tl2; if (e2 == e) mine = tl2; }
            tl[336 + e] = acc * 256; tl[384 + e] = acc * 256 + tl[416 + e];
            for (int t = 0; t < mine; ++t) tl[acc + t] = e;
            if (e == 0) tl[320] = tot;
        }
        __syncthreads();
        if (bid < E_) { const int b0 = tl[336 + bid], cnt = tl[448 + bid], end = b0 + (cnt + 255) / 256 * 256;
            for (int i = b0 + cnt + tid; i < end; i += 512) sm[SM_ROWTOK + i] = 0; }
        {
            if (tid < 256) { const int pidx = 256 * bid + tid; const int e = ((const LAS int*)(lds + RT_KEEP))[tid * 2]; const float gte = ((const LAS float*)(lds + RT_KEEP))[tid * 2 + 1];
                const int pos = tl[384 + e] + __hip_atomic_fetch_add(tl + 480 + e, 1, __ATOMIC_RELAXED, __HIP_MEMORY_SCOPE_WORKGROUP);
                ((float*)sm)[SM_ROWGATE + pos] = gte; sm[SM_PAIRROW + pidx] = pos; sm[SM_ROWTOK + pos] = pidx >> 2; }
        }
    }
    xcd_barrier(bar);
    const int nt = __builtin_amdgcn_readfirstlane(tl[320]);
    for (int rep = 0; rep < REP_MOE; ++rep) {
        pg8::Gemm g{XN, WGU, ROWS_PAD, E_ * 2 * FF, D_ / 2};
        pg8::MoeOrder S{tl, nt, 8, bid};
        pg8::EpiSwiglu8 E{ws + WS_ACT, KA(gu_b)};
        pg8::gemm_phase<pg8::EpiSwiglu8, pg8::MoeOrder, true, true, true, true>(lds, g, S, E, wave_s, sm + SM_ROWTOK);
        {
            PHASE_IDS();
            constexpr int I_DN = (FF / 64) * (D_ / 32), NQ = E_ * I_DN - (TAIL_ITEMS - TAIL_GU); const float* dn_w_ = KA(dn_w); LAS float* scr = (LAS float*)(lds + wave * 16384);
            for (;;) {
                if (tid == 0) MISC[40] = xb_add(&ctl[CW_Q], 16u);
                __syncthreads();
                const int it = (int)MISC[40] + 2 * wave;
                __syncthreads();
                if (it - 2 * wave >= NQ) break;
#pragma unroll 1
                for (int k = 0; k < 2; ++k) { const int r = it + k; if (r < NQ) { const int e = r / I_DN;
                    if (it < (NQ * 2) / 5) transpose_item8<MapDN, true>(dn_w_ + (size_t)e * FF * D_, FF, D_, (unsigned char*)WDN, MapDN{e}, scr, r % I_DN, lane);
                    else transpose_item8(dn_w_ + (size_t)e * FF * D_, FF, D_, (unsigned char*)WDN, MapDN{e}, scr, r % I_DN, lane); } }
            }
        }
    }
    xcd_barrier(bar);
    for (int rep = 0; rep < REP_MOE; ++rep) {
        pg8::Gemm g{(const bf16_t*)(ws + WS_ACT), WDN, ROWS_PAD, E_ * D_, FF / 2};
        pg8::MoeOrder S{tl, nt, 4, bid};
        pg8::EpiDown8 E{ws + WS_YB, KA(dn_b), (const float*)(sm + SM_ROWGATE)};
        pg8::gemm_phase<pg8::EpiDown8, pg8::MoeOrder, true, true, true>(lds, g, S, E, wave_s);
    }
    xcd_barrier(bar);
    for (int rep = 0; rep < REP_P10; ++rep) { PHASE_IDS(); const float* nfin_ = KA(nfinal); float* out_ = KA(out);
        int nx[4];
#pragma unroll
        for (int k = 0; k < 4; ++k) nx[k] = sm[SM_PAIRROW + gw * 4 + k];
        for (int row = gw; row < T_; row += NGW) { const int cur[4] = {nx[0], nx[1], nx[2], nx[3]}; const int rn = (row + NGW < T_) ? row + NGW : row;
#pragma unroll
            for (int k = 0; k < 4; ++k) nx[k] = sm[SM_PAIRROW + rn * 4 + k];
            final_row((const bf16_t*)(ws + WS_H1), ws + WS_YB, nfin_, out_, row, lane, cur); } }
}
}

extern "C" void kernel_launch(void* const* d_in, const int* in_sizes, int n_in, void* d_out, int out_size, void* d_ws, size_t ws_size, hipStream_t stream) {
    static bool inited = false;
    if (!inited) { (void)hipFuncSetAttribute((const void*)mega_fwd, hipFuncAttributeMaxDynamicSharedMemorySize, LDS_BYTES); inited = true; }
    Args a{};
    a.x = (const float*)d_in[0]; a.nmw = (const float*)d_in[1]; a.w_in = (const float*)d_in[2]; a.conv_w = (const float*)d_in[3]; a.mu = (const float*)d_in[4]; a.w0 = (const float*)d_in[5];
    a.wdu = (const float*)d_in[6]; a.a0 = (const float*)d_in[7]; a.wiu = (const float*)d_in[8]; a.wgu = (const float*)d_in[9]; a.k_k = (const float*)d_in[10]; a.k_a = (const float*)d_in[11];
    a.r_k = (const float*)d_in[12]; a.lnw = (const float*)d_in[13]; a.lnb = (const float*)d_in[14]; a.w_out = (const float*)d_in[15]; a.nfw = (const float*)d_in[16]; a.rw = (const float*)d_in[17];
    a.rb = (const float*)d_in[18]; a.gu_w = (const float*)d_in[19]; a.gu_b = (const float*)d_in[20]; a.dn_w = (const float*)d_in[21]; a.dn_b = (const float*)d_in[22]; a.nfinal = (const float*)d_in[23];
    a.out = (float*)d_out; a.ws = (unsigned char*)d_ws;
    (void)hipMemsetAsync((unsigned char*)d_ws + WS_CTL + (size_t)CW_BAR * 4, 0, 16384, stream);
    mega_fwd<<<GRID, NTHR, LDS_BYTES, stream>>>(a);
}
```
